# Optimizing an MI355X kernel written in HIP

```python
import math
import jax, jax.numpy as jnp
from jax import lax
import numpy as np

D_MODEL = 2048
BATCH = 2
SEQ = 16384
DEPTH = 2
DEC_BATCH = 32
DEC_SEQ = 64
PAST_LEN = 2048

CHUNK = 64
D_MIX = D_MODEL
SSM_WIDTH = D_MIX // 4
ATTN_WIDTH = D_MIX // 2
CONV_WIDTH = D_MIX - SSM_WIDTH - ATTN_WIDTH
SSM_GROUP = 16
SSM_GROUPS = SSM_WIDTH // SSM_GROUP
SSM_STATE = 64
HEAD_DIM = 64
N_HEADS = ATTN_WIDTH // HEAD_DIM
N_KV_HEADS = 2
Q_PER_KV = N_HEADS // N_KV_HEADS
KV_WIDTH = N_KV_HEADS * HEAD_DIM
WINDOW = 128
WINDOW_CHUNKS = WINDOW // CHUNK
BAND = (WINDOW_CHUNKS + 1) * CHUNK
CONV_K = 3
D_FF = 4 * D_MODEL
REL_BUCKETS = 32
REL_MAX_DIST = 64
EPS = 1e-6
NEG_INF = -1e30
IN_COLS = SSM_WIDTH + ATTN_WIDTH + 2 * KV_WIDTH + 3 * CONV_WIDTH

kernel_name = 'hybrid_streaming_encoder_step'


def rmsnorm(x, gain=None):
    xf = x.astype(jnp.float32)
    y = xf * lax.rsqrt(jnp.mean(xf * xf, axis=-1, keepdims=True) + EPS)
    if gain is not None:
        y = y * gain.astype(jnp.float32)
    return y.astype(x.dtype)


def rel_bias_block(table, n_q, n_k, key_offset):
    qi = jnp.arange(n_q)[:, None]
    ks = jnp.arange(n_k)[None, :]
    rel = ks - key_offset - qi
    half = REL_BUCKETS // 2
    exact = half // 2
    n = jnp.abs(rel)
    nf = jnp.maximum(n, 1).astype(jnp.float32)
    far = exact + (jnp.log(nf / exact) / math.log(REL_MAX_DIST / exact) * (half - exact)).astype(jnp.int32)
    far = jnp.minimum(far, half - 1)
    bucket = jnp.where(rel > 0, half, 0) + jnp.where(n < exact, n, far)
    bias = table[bucket].astype(jnp.float32)
    return jnp.transpose(bias, (2, 0, 1)).reshape(N_KV_HEADS, Q_PER_KV, n_q, n_k)


def sink_attention(q, k, v, bias, sinks, key_mask):
    logits = jnp.einsum('bnqkgd,bnskd->bnkgqs', q, k, preferred_element_type=jnp.float32)
    logits = logits * (HEAD_DIM ** -0.5) + bias
    if key_mask is not None:
        logits = jnp.where(key_mask[None, :, None, None, None, :], logits, NEG_INF)
    sink = sinks.astype(jnp.float32).reshape(1, 1, N_KV_HEADS, Q_PER_KV, 1, 1)
    m = jnp.maximum(jnp.max(logits, axis=-1, keepdims=True), sink)
    p = jnp.exp(logits - m)
    probs = p / (jnp.sum(p, axis=-1, keepdims=True) + jnp.exp(sink - m))
    return jnp.einsum('bnkgqs,bnskd->bnqkgd', probs.astype(v.dtype), v)


def band_attention_prompt(q, k, v, bias, sinks):
    b, L = q.shape[0], q.shape[1]
    nc = L // CHUNK
    qc = q.reshape(b, nc, CHUNK, N_KV_HEADS, Q_PER_KV, HEAD_DIM)

    def band(t):
        tp = jnp.pad(t, ((0, 0), (WINDOW, 0), (0, 0), (0, 0)))
        tp = tp.reshape(b, nc + WINDOW_CHUNKS, CHUNK, N_KV_HEADS, HEAD_DIM)
        return jnp.concatenate([tp[:, j:j + nc] for j in range(WINDOW_CHUNKS + 1)], axis=2)

    key_pos = jnp.arange(nc)[:, None] * CHUNK - WINDOW + jnp.arange(BAND)[None, :]
    out = sink_attention(qc, band(k), band(v), bias, sinks, key_pos >= 0)
    return out.reshape(b, L, ATTN_WIDTH)


def _complex_affine_combine(e1, e2):
    a1r, a1i, b1r, b1i = e1
    a2r, a2i, b2r, b2i = e2
    ar = a1r * a2r - a1i * a2i
    ai = a1r * a2i + a1i * a2r
    br = a2r * b1r - a2i * b1i + b2r
    bi = a2r * b1i + a2i * b1r + b2i
    return ar, ai, br, bi


def ssm_mixer(u, a_re, a_im, log_dt, b_re, b_im, c_re, c_im, d_skip, w_glu, h0_re, h0_im):
    f32 = jnp.float32
    b, L = u.shape[0], u.shape[1]
    uf = u.astype(f32).reshape(b, L, SSM_GROUPS, SSM_GROUP)
    ar, ai = a_re.astype(f32), a_im.astype(f32)
    dt = jnp.exp(log_dt.astype(f32))[:, None]
    mag = jnp.exp(dt * ar)
    abar_re, abar_im = mag * jnp.cos(dt * ai), mag * jnp.sin(dt * ai)
    den = ar * ar + ai * ai
    f_re = ((abar_re - 1.0) * ar + abar_im * ai) / den
    f_im = (abar_im * ar - (abar_re - 1.0) * ai) / den
    bu_re = jnp.einsum('blgh,gph->blgp', uf, b_re.astype(f32))
    bu_im = jnp.einsum('blgh,gph->blgp', uf, b_im.astype(f32))
    bb_re = f_re * bu_re - f_im * bu_im
    bb_im = f_re * bu_im + f_im * bu_re
    shape = (1, L, SSM_GROUPS, SSM_STATE)
    ac_re, ac_im, h_re, h_im = lax.associative_scan(
        _complex_affine_combine,
        (jnp.broadcast_to(abar_re, shape), jnp.broadcast_to(abar_im, shape), bb_re, bb_im),
        axis=1)
    if h0_re is not None:
        g_re = h0_re.astype(f32)[:, None]
        g_im = h0_im.astype(f32)[:, None]
        h_re, h_im = (h_re + ac_re * g_re - ac_im * g_im,
                      h_im + ac_re * g_im + ac_im * g_re)
    y = (jnp.einsum('blgp,ghp->blgh', h_re, c_re.astype(f32))
         - jnp.einsum('blgp,ghp->blgh', h_im, c_im.astype(f32))
         + d_skip.astype(f32).reshape(SSM_GROUPS, SSM_GROUP) * uf)
    y = jax.nn.gelu(y.reshape(b, L, SSM_WIDTH))
    y = y * jax.nn.sigmoid(y @ w_glu.astype(f32))
    return y.astype(u.dtype), h_re[:, -1], h_im[:, -1]


def causal_conv(zp, w, L):
    return sum(zp[:, j:j + L] * w[:, j] for j in range(CONV_K))


def trunk_layer(x, mod, bias, w_in, a_re, a_im, log_dt, b_re, b_im, c_re, c_im, d_skip, w_glu,
                q_g, k_g, sinks, conv_w, out_g, w_out, w_ff1, w_ff2,
                kv_k=None, kv_v=None, h0_re=None, h0_im=None, conv_buf=None):
    b, L = x.shape[0], x.shape[1]
    shift1, scale1, gate1, shift2, scale2, gate2 = jnp.split(mod[:, None, :], 6, axis=-1)
    h = rmsnorm(x) * (1.0 + scale1) + shift1
    proj = h @ w_in
    sizes = [SSM_WIDTH, ATTN_WIDTH, KV_WIDTH, KV_WIDTH, CONV_WIDTH, CONV_WIDTH, CONV_WIDTH]
    u, q, k, v, gb, gc, xc = jnp.split(proj, np.cumsum(sizes)[:-1].tolist(), axis=-1)

    y_ssm, new_re, new_im = ssm_mixer(u, a_re, a_im, log_dt, b_re, b_im, c_re, c_im, d_skip, w_glu, h0_re, h0_im)

    q = rmsnorm(q.reshape(b, L, N_HEADS, HEAD_DIM), q_g)
    k = rmsnorm(k.reshape(b, L, N_KV_HEADS, HEAD_DIM), k_g)
    v = v.reshape(b, L, N_KV_HEADS, HEAD_DIM)
    if kv_k is None:
        y_attn = band_attention_prompt(q, k, v, bias, sinks)
        new_k, new_v = k[:, -WINDOW:], v[:, -WINDOW:]
    else:
        n_buf = kv_k.shape[1]
        kf = jnp.concatenate([kv_k.astype(k.dtype), k], axis=1)
        vf = jnp.concatenate([kv_v.astype(v.dtype), v], axis=1)
        qg = q.reshape(b, 1, L, N_KV_HEADS, Q_PER_KV, HEAD_DIM)
        y_attn = sink_attention(qg, kf[:, None], vf[:, None], bias, sinks, None).reshape(b, L, ATTN_WIDTH)
        new_k, new_v = kf[:, -n_buf:], vf[:, -n_buf:]

    z = gc * xc
    if conv_buf is None:
        conv_buf = jnp.zeros((b, CONV_K - 1, CONV_WIDTH), z.dtype)
    zp = jnp.concatenate([conv_buf.astype(z.dtype), z], axis=1)
    y_conv = gb * causal_conv(zp, conv_w, L)
    new_conv = zp[:, -(CONV_K - 1):]

    y = jnp.concatenate([rmsnorm(y_ssm), rmsnorm(y_attn), rmsnorm(y_conv)], axis=-1) * out_g
    x = x + gate1 * (y @ w_out)

    h2 = rmsnorm(x) * (1.0 + scale2) + shift2
    x = x + gate2 * (jnp.square(jax.nn.relu(h2 @ w_ff1)) @ w_ff2)
    return x, new_k, new_v, new_re, new_im, new_conv


def setup_inputs(seed: int = 0) -> dict:
    key = jax.random.key(seed)
    ks = jax.random.split(key, 32)
    f32 = jnp.float32

    def nrm(k, shape, scale):
        return scale * jax.random.normal(k, shape, f32)

    n_buf = min(WINDOW, PAST_LEN)
    p_idx = jnp.arange(SSM_STATE, dtype=f32)
    return {
        'x_prompt': nrm(ks[0], (BATCH, SEQ, D_MODEL), 1.0),
        'x_sample': nrm(ks[1], (DEC_BATCH, DEC_SEQ, D_MODEL), 1.0),
        'cache_k': nrm(ks[2], (DEPTH, DEC_BATCH, n_buf, N_KV_HEADS, HEAD_DIM), 1.0),
        'cache_v': nrm(ks[3], (DEPTH, DEC_BATCH, n_buf, N_KV_HEADS, HEAD_DIM), 1.0),
        'state_ssm_re': nrm(ks[4], (DEPTH, DEC_BATCH, SSM_GROUPS, SSM_STATE), 0.3),
        'state_ssm_im': nrm(ks[5], (DEPTH, DEC_BATCH, SSM_GROUPS, SSM_STATE), 0.3),
        'state_conv': nrm(ks[6], (DEPTH, DEC_BATCH, CONV_K - 1, CONV_WIDTH), 1.0),
        'c_prompt': nrm(ks[7], (BATCH, D_MODEL), 1.0),
        'c_sample': nrm(ks[8], (DEC_BATCH, D_MODEL), 1.0),
        'rel_bias': nrm(ks[9], (REL_BUCKETS, N_HEADS), 0.5),
        'w_ada': nrm(ks[10], (DEPTH, D_MODEL, 6 * D_MODEL), 0.3 * D_MODEL ** -0.5),
        'b_ada': nrm(ks[11], (DEPTH, 6 * D_MODEL), 0.02),
        'w_in': nrm(ks[12], (DEPTH, D_MODEL, IN_COLS), D_MODEL ** -0.5),
        'ssm_a_re': -0.5 + nrm(ks[13], (DEPTH, SSM_GROUPS, SSM_STATE), 0.01),
        'ssm_a_im': math.pi * p_idx + nrm(ks[14], (DEPTH, SSM_GROUPS, SSM_STATE), 0.01),
        'ssm_log_dt': jax.random.uniform(ks[15], (DEPTH, SSM_GROUPS), f32, math.log(0.001), math.log(0.1)),
        'ssm_b_re': nrm(ks[16], (DEPTH, SSM_GROUPS, SSM_STATE, SSM_GROUP), (2 * SSM_GROUP) ** -0.5),
        'ssm_b_im': nrm(ks[17], (DEPTH, SSM_GROUPS, SSM_STATE, SSM_GROUP), (2 * SSM_GROUP) ** -0.5),
        'ssm_c_re': nrm(ks[18], (DEPTH, SSM_GROUPS, SSM_GROUP, SSM_STATE), (2 * SSM_STATE) ** -0.5),
        'ssm_c_im': nrm(ks[19], (DEPTH, SSM_GROUPS, SSM_GROUP, SSM_STATE), (2 * SSM_STATE) ** -0.5),
        'ssm_d': nrm(ks[20], (DEPTH, SSM_WIDTH), 1.0),
        'ssm_w_glu': nrm(ks[21], (DEPTH, SSM_WIDTH, SSM_WIDTH), SSM_WIDTH ** -0.5),
        'q_norm_g': 1.0 + nrm(ks[22], (DEPTH, HEAD_DIM), 0.05),
        'k_norm_g': 1.0 + nrm(ks[23], (DEPTH, HEAD_DIM), 0.05),
        'attn_sinks': nrm(ks[24], (DEPTH, N_HEADS), 1.0),
        'conv_w': nrm(ks[25], (DEPTH, CONV_WIDTH, CONV_K), CONV_K ** -0.5),
        'out_norm_g': 1.0 + nrm(ks[26], (DEPTH, D_MIX), 0.05),
        'w_out': nrm(ks[27], (DEPTH, D_MIX, D_MODEL), D_MIX ** -0.5),
        'w_ff1': nrm(ks[28], (DEPTH, D_MODEL, D_FF), D_MODEL ** -0.5),
        'w_ff2': nrm(ks[29], (DEPTH, D_FF, D_MODEL), D_FF ** -0.5),
    }


def reference(x_prompt, x_sample, cache_k, cache_v, state_ssm_re, state_ssm_im, state_conv,
              c_prompt, c_sample, rel_bias, w_ada, b_ada, w_in, ssm_a_re, ssm_a_im, ssm_log_dt,
              ssm_b_re, ssm_b_im, ssm_c_re, ssm_c_im, ssm_d, ssm_w_glu, q_norm_g, k_norm_g,
              attn_sinks, conv_w, out_norm_g, w_out, w_ff1, w_ff2):
    n_buf = cache_k.shape[2]
    s_new = x_sample.shape[1]
    bias_prompt = rel_bias_block(rel_bias, CHUNK, BAND, WINDOW)
    bias_sample = rel_bias_block(rel_bias, s_new, n_buf + s_new, n_buf)
    xp, xs = x_prompt, x_sample
    kp_l, vp_l, rp_l, ip_l, cp_l = [], [], [], [], []
    ks_l, vs_l, rs_l, is_l, cs_l = [], [], [], [], []
    for l in range(DEPTH):
        lw = (w_in[l], ssm_a_re[l], ssm_a_im[l], ssm_log_dt[l], ssm_b_re[l], ssm_b_im[l],
              ssm_c_re[l], ssm_c_im[l], ssm_d[l], ssm_w_glu[l], q_norm_g[l], k_norm_g[l],
              attn_sinks[l], conv_w[l], out_norm_g[l], w_out[l], w_ff1[l], w_ff2[l])
        mod_p = jax.nn.silu(c_prompt) @ w_ada[l] + b_ada[l]
        mod_s = jax.nn.silu(c_sample) @ w_ada[l] + b_ada[l]
        xp, kp, vp, rp, ip, cp = trunk_layer(xp, mod_p, bias_prompt, *lw)
        xs, ks, vs, rs, is_, cs = trunk_layer(xs, mod_s, bias_sample, *lw,
                                              cache_k[l], cache_v[l], state_ssm_re[l],
                                              state_ssm_im[l], state_conv[l])
        kp_l.append(kp); vp_l.append(vp); rp_l.append(rp); ip_l.append(ip); cp_l.append(cp)
        ks_l.append(ks); vs_l.append(vs); rs_l.append(rs); is_l.append(is_); cs_l.append(cs)
    return (xp, xs,
            jnp.stack(kp_l), jnp.stack(vp_l), jnp.stack(rp_l), jnp.stack(ip_l), jnp.stack(cp_l),
            jnp.stack(ks_l), jnp.stack(vs_l), jnp.stack(rs_l), jnp.stack(is_l), jnp.stack(cs_l))
```

```cpp
#include <hip/hip_runtime.h>
#include <hip/hip_cooperative_groups.h>
#include <cstdio>
namespace cg = cooperative_groups;

#define LAS __attribute__((address_space(3)))
typedef unsigned short bf16_t;
typedef short bf16x8 __attribute__((ext_vector_type(8)));
typedef float f32x4 __attribute__((ext_vector_type(4)));
typedef float f32x2 __attribute__((ext_vector_type(2)));
typedef float f32x16 __attribute__((ext_vector_type(16)));
typedef unsigned u32x4 __attribute__((ext_vector_type(4)));
typedef unsigned u32x2 __attribute__((ext_vector_type(2)));

constexpr int D = 2048, TP = 32768, TS = 2048, T = TP + TS, SEQ = 16384, NIN = 3328, NPJ = 2816, DFF = 8192, NB = 34, NMOD = 12288;
constexpr int PJ_K = 1024, PJ_V = 1152, PJ_GB = 1280, PJ_GC = 1792, PJ_XC = 2304;
constexpr int U2_ROWS = 768, U2_LD = 1280;
constexpr float EPS = 1e-6f;
constexpr size_t O_Y = 0;
constexpr size_t O_NKP = (size_t)T * D;
constexpr size_t O_NVP = O_NKP + 2 * 2 * 128 * 128;
constexpr size_t O_SRP = O_NVP + 2 * 2 * 128 * 128;
constexpr size_t O_SIP = O_SRP + 2 * 2 * 32 * 64;
constexpr size_t O_NCP = O_SIP + 2 * 2 * 32 * 64;
constexpr size_t O_NKS = O_NCP + 2 * 2 * 2 * 512;
constexpr size_t O_NVS = O_NKS + (size_t)2 * 32 * 128 * 128;
constexpr size_t O_SRS = O_NVS + (size_t)2 * 32 * 128 * 128;
constexpr size_t O_SIS = O_SRS + 2 * 32 * 32 * 64;
constexpr size_t O_NCS = O_SIS + 2 * 32 * 32 * 64;
constexpr size_t O_END = O_NCS + 2 * 32 * 2 * 512;
constexpr size_t MiB = 1u << 20;
constexpr size_t WS_BIAS = 1 * MiB;
constexpr size_t WS_A64 = 1 * MiB + 65536;
constexpr size_t WS_MOD = 2 * MiB;
constexpr size_t WS_W = 8 * MiB;
constexpr size_t WPL = 85 * MiB + MiB / 2;
constexpr size_t W_IN = 0, W_OUT = 13 * MiB, W_FF1 = 21 * MiB, W_FF2 = 53 * MiB, W_GLU = 85 * MiB;
constexpr size_t WS_MT = 180 * MiB;
constexpr size_t WS_EM = 260 * MiB;
constexpr size_t WS_XN = 276 * MiB;
constexpr size_t WS_HID = 412 * MiB;
constexpr size_t WS_PROJ = 412 * MiB;
constexpr size_t WS_U2 = 599 * MiB;
constexpr size_t WS_E = 659 * MiB;
constexpr size_t WS_YG = 683 * MiB;
constexpr size_t WS_YT = 717 * MiB;
constexpr size_t WS_END = 1024 * MiB;
constexpr int LDS_BYTES = 147456;
constexpr int NPH = 23;
#ifndef TR_HEAD
#define TR_HEAD 0
#endif
#ifndef AUX_FF2A
#define AUX_FF2A 0
#endif

struct Args { const float* in[30]; float* out; unsigned char* ws; int ph_lo, ph_hi; };
typedef const __attribute__((address_space(4))) Args* CArgs;

__device__ __forceinline__ unsigned f2bf(float f) { unsigned u = __builtin_bit_cast(unsigned, f); return (u + 0x7fffu + ((u >> 16) & 1u)) >> 16; }
typedef __bf16 bf16x2_t __attribute__((ext_vector_type(2)));
__device__ __forceinline__ unsigned pk2(float lo, float hi) { const f32x2 v = {lo, hi}; return __builtin_bit_cast(unsigned, __builtin_convertvector(v, bf16x2_t)); }
__device__ __forceinline__ float bflo(unsigned u) { return __builtin_bit_cast(float, u << 16); }
__device__ __forceinline__ float bfhi(unsigned u) { return __builtin_bit_cast(float, u & 0xffff0000u); }
__device__ __forceinline__ void unpack8(u32x4 w, float* f) { f[0] = bflo(w.x); f[1] = bfhi(w.x); f[2] = bflo(w.y); f[3] = bfhi(w.y); f[4] = bflo(w.z); f[5] = bfhi(w.z); f[6] = bflo(w.w); f[7] = bfhi(w.w); }
__device__ __forceinline__ float wave_sum(float v) {
#pragma unroll
    for (int o = 1; o < 64; o <<= 1) v += __shfl_xor(v, o);
    return v;
}
__device__ __forceinline__ int batch_of(int row) { return row < TP ? (row >> 14) : 2 + ((row - TP) >> 6); }
__device__ __forceinline__ float gelu_tanh(float x) { const float u = 0.7978845608028654f * (x + 0.044715f * x * x * x); return x / (1.0f + __expf(-2.0f * u)); }


struct XBuf { const unsigned char* p0; const unsigned char* p1; int split; int f32; };
__device__ __forceinline__ const unsigned char* xrow(const XBuf& b, int row) { return (row < b.split ? b.p0 : b.p1) + (size_t)row * (b.f32 ? 8192 : 4096); }
__device__ __forceinline__ void xload8(const XBuf& b, int row, int col, float* v) {
    const unsigned char* r = xrow(b, row);
    if (b.f32) { const f32x4 a0 = *(const f32x4*)(r + (size_t)col * 4), a1 = *(const f32x4*)(r + (size_t)col * 4 + 16);
#pragma unroll
        for (int j = 0; j < 4; ++j) { v[j] = a0[j]; v[4 + j] = a1[j]; } }
    else unpack8(*(const u32x4*)(r + (size_t)col * 2), v);
}
__device__ __forceinline__ void xstore8(const XBuf& b, int row, int col, const float* v) {
    unsigned char* r = (unsigned char*)xrow(b, row);
    if (b.f32) { *(f32x4*)(r + (size_t)col * 4) = (f32x4){v[0], v[1], v[2], v[3]}; *(f32x4*)(r + (size_t)col * 4 + 16) = (f32x4){v[4], v[5], v[6], v[7]}; }
    else { u32x4 w; w.x = pk2(v[0], v[1]); w.y = pk2(v[2], v[3]); w.z = pk2(v[4], v[5]); w.w = pk2(v[6], v[7]); *(u32x4*)(r + (size_t)col * 2) = w; }
}

namespace pg8 {
constexpr int BM = 256, BK = 64, HALF = 128, HTB = HALF * BK * 2, STAGE_BYTES = 8 * HTB, NXCD = 8, WGM = 4;
__device__ __forceinline__ int lds_byte(int r, int c) { const int st = (r >> 4) * 2 + (c >> 5), rr = r & 15, cc = c & 31, ob = rr * 64 + cc * 2; return st * 1024 + (ob ^ (((ob >> 9) & 1) << 5)); }
__device__ __forceinline__ void stage_rc(int b, int& R, int& C) { const int st = b / 1024, sb = b % 1024, swz = sb ^ (((sb >> 9) & 1) << 5); R = (st >> 1) * 16 + swz / 64; C = (st & 1) * 32 + (swz % 64) / 2; }
__device__ __forceinline__ int perm32(int rho) { const int n = rho >> 4, i = rho & 15; return 8 * (i >> 2) + 4 * n + (i & 3); }
struct Unit { int pm, pn, k0, nt, tl; };
struct Gemm { const bf16_t* A; const bf16_t* Bt; int lda, ldb, K; };
struct StaticOrder {
    int nM, nN, nwg, G, c, ntf, nfull, split;
    __device__ __forceinline__ void init(int M, int N, int K, int G_, int c_, bool ksplit = false) { nM = M / BM; nN = N / BM; nwg = nM * nN; G = G_; c = c_; ntf = K / BK; nfull = nwg; split = 1;
        if (ksplit) { const int tail = nwg % G; if (tail > 0 && G % tail == 0 && (ntf % (2 * (G / tail))) == 0) { nfull = nwg - tail; split = G / tail; } } }
    __device__ __forceinline__ bool next(int i, Unit& u) const {
        const int L = i * G + c; int wgid, k0 = 0, nt = ntf, tl = -1;
        if (L < nfull) wgid = L;
        else { tl = L - nfull; if (tl >= (nwg - nfull) * split) return false; wgid = nfull + tl / split; nt = ntf / split; k0 = (tl % split) * nt * BK; }
        { const int q = nwg / NXCD, r = nwg % NXCD, xcd = wgid % NXCD, off = wgid / NXCD; wgid = (xcd < r ? xcd * (q + 1) : r * (q + 1) + (xcd - r) * q) + off; }
        const int nig = WGM * nN, gid = wgid / nig, fm = gid * WGM, gsz = (nM - fm) < WGM ? (nM - fm) : WGM;
        u.pm = fm + ((wgid % nig) % gsz); u.pn = (wgid % nig) / gsz; u.k0 = k0; u.nt = nt; u.tl = tl; return true;
    }
    __device__ __forceinline__ void tile_of(int wgid, int& pm, int& pn) const {
        { const int q = nwg / NXCD, r = nwg % NXCD, xcd = wgid % NXCD, off = wgid / NXCD; wgid = (xcd < r ? xcd * (q + 1) : r * (q + 1) + (xcd - r) * q) + off; }
        const int nig = WGM * nN, gid = wgid / nig, fm = gid * WGM, gsz = (nM - fm) < WGM ? (nM - fm) : WGM;
        pm = fm + ((wgid % nig) % gsz); pn = (wgid % nig) / gsz; }
};
struct FF1Order { int G, c;
    __device__ __forceinline__ bool next(int i, Unit& u) const { if (i >= 17) return false; const int xcd = c & 7, r = c >> 3; u.pm = 8 * i + (r & 7); u.pn = 4 * xcd + (r >> 3); u.k0 = 0; u.nt = 32; u.tl = -1; return true; } };
struct GluOrder { int G, c;
    __device__ __forceinline__ bool next(int i, Unit& u) const { const int pm = c + (i >> 1) * G; if (i > 1 || pm >= T / 256) return false; u.pm = pm; u.pn = i & 1; u.k0 = 0; u.nt = 8; u.tl = -1; return true; } };
struct S1Order { int G, c;
    __device__ __forceinline__ bool next(int i, Unit& u) const { const int L = i * G + c; if (L >= 96) return false; u.pm = L; u.pn = L / 3; u.k0 = 0; u.nt = 16; u.tl = -1; return true; } };
struct S2XcdOrder { int G, c;
    __device__ __forceinline__ bool next(int i, Unit& u) const { const int x = c & 7, u48 = (c >> 3) + 32 * i; if (i > 1 || u48 >= 48) return false;
        const int g = 4 * x + u48 / 12, r = u48 % 12; u.pm = g * 3 + (r >> 2); u.pn = g * 4 + (r & 3); u.k0 = 0; u.nt = 20; u.tl = -1; return true; } };
struct S2Order { int G, c;
    __device__ __forceinline__ bool next(int i, Unit& u) const { const int L = i * G + c; if (L >= 384) return false; const int g = L / 12, r = L % 12; u.pm = g * 3 + (r >> 2); u.pn = g * 4 + (r & 3); u.k0 = 0; u.nt = 20; u.tl = -1; return true; } };

template <int AUXA = 0, class Epi, class Sched>
__device__ __forceinline__ void gemm_phase(LAS unsigned char* lds, const int tid, const Gemm g, const Sched& S, const Epi& E) {
    const int wid = __builtin_amdgcn_readfirstlane(tid >> 6), lane = tid & 63, wr = wid >> 2, wc = wid & 3, fr = lane & 15, fq = lane >> 4;
    unsigned voffA[2], voffB[2];
#pragma unroll
    for (int i = 0; i < 2; ++i) { int R, C; stage_rc(tid * 16 + i * 8192, R, C); const int Rb = Epi::PERM ? ((R & ~31) + perm32(R & 31)) : R;
        voffA[i] = (unsigned)(R * g.lda + C) * 2u; voffB[i] = (unsigned)(Rb * g.ldb + C) * 2u; }
    const size_t kstep = (size_t)(BK * 2);
    const size_t hstepA = (size_t)HALF * g.lda * 2, hstepB = (size_t)HALF * g.ldb * 2;
    const size_t tstepA = 2 * hstepA, tstepB = 2 * hstepB;
    const unsigned ldsw = (unsigned)wid * 1024u;
    const int aoff = lds_byte(wr * 64 + fr, fq * 8), boff = lds_byte(wc * 32 + fr, fq * 8);
#define PG8_SA(b, h) (((b) * 2 + (h)) * HTB)
#define PG8_SB(b, h) ((4 + (b) * 2 + (h)) * HTB)
#define PG8_STAGE(bufoff, gbase, voff) do { _Pragma("unroll") for (int _i = 0; _i < 2; ++_i) \
        __builtin_amdgcn_global_load_lds((const unsigned*)((const char*)(gbase) + (voff)[_i]), (LAS unsigned*)(lds + (bufoff) + ldsw + _i * 8192), 16, 0, 0); } while (0)
#define PG8_STAGEA(bufoff, gbase, voff) do { _Pragma("unroll") for (int _i = 0; _i < 2; ++_i) \
        __builtin_amdgcn_global_load_lds((const unsigned*)((const char*)(gbase) + (voff)[_i]), (LAS unsigned*)(lds + (bufoff) + ldsw + _i * 8192), 16, 0, AUXA); } while (0)
#define PG8_LDA(dst, b, h) do { _Pragma("unroll") for (int m = 0; m < 4; ++m) _Pragma("unroll") for (int k = 0; k < 2; ++k) dst[m][k] = *(const LAS bf16x8*)(lds + PG8_SA(b, h) + aoff + m * 2048 + k * 1024); } while (0)
#define PG8_LDB(dst, b, h) do { _Pragma("unroll") for (int n = 0; n < 2; ++n) _Pragma("unroll") for (int k = 0; k < 2; ++k) dst[n][k] = *(const LAS bf16x8*)(lds + PG8_SB(b, h) + boff + n * 2048 + k * 1024); } while (0)
#define PG8_MMA(ai, bj, At, Bt) do { __builtin_amdgcn_s_setprio(1); _Pragma("unroll") for (int m = 0; m < 4; ++m) _Pragma("unroll") for (int n = 0; n < 2; ++n) _Pragma("unroll") for (int k = 0; k < 2; ++k) \
        acc[ai][bj][m][n] = __builtin_amdgcn_mfma_f32_16x16x32_bf16(Bt[n][k], At[m][k], acc[ai][bj][m][n], 0, 0, 0); __builtin_amdgcn_s_setprio(0); } while (0)
#define PG8_WAIT_V(n) asm volatile("s_waitcnt vmcnt(" #n ")" ::: "memory")
#define PG8_WAIT_L(n) asm volatile("s_waitcnt lgkmcnt(" #n ")" ::: "memory")
#define PG8_BAR __builtin_amdgcn_s_barrier()
#define PG8_SCHED __builtin_amdgcn_sched_barrier(0)
    Unit cur, nxt; int ui = 0;
    if (!S.next(0, cur)) return;
    f32x4 acc[2][2][4][2];
#pragma unroll
    for (int a = 0; a < 2; ++a)
#pragma unroll
        for (int b = 0; b < 2; ++b)
#pragma unroll
            for (int m = 0; m < 4; ++m)
#pragma unroll
                for (int n = 0; n < 2; ++n) acc[a][b][m][n] = (f32x4){0.f, 0.f, 0.f, 0.f};
    bf16x8 At[4][2], B0[2][2], B1[2][2];
    const char* cA = (const char*)g.A + (size_t)cur.pm * tstepA + (size_t)cur.k0 * 2; const char* cB = (const char*)g.Bt + (size_t)cur.pn * tstepB + (size_t)cur.k0 * 2;
    PG8_STAGE(PG8_SB(0, 0), cB, voffB); PG8_STAGE(PG8_SB(0, 1), cB + hstepB, voffB); PG8_STAGEA(PG8_SA(0, 0), cA, voffA); PG8_STAGEA(PG8_SA(0, 1), cA + hstepA, voffA);
    if (wr == 1) PG8_BAR;
    PG8_WAIT_V(2); PG8_BAR;
    PG8_STAGE(PG8_SB(1, 0), cB + kstep, voffB); PG8_STAGEA(PG8_SA(1, 0), cA + kstep, voffA); PG8_STAGE(PG8_SB(1, 1), cB + hstepB + kstep, voffB);
    PG8_WAIT_V(6); PG8_BAR;
    for (;;) {
        const bool has_next = S.next(ui + 1, nxt);
        const char* nA = has_next ? (const char*)g.A + (size_t)nxt.pm * tstepA + (size_t)nxt.k0 * 2 : cA; const char* nB = has_next ? (const char*)g.Bt + (size_t)nxt.pn * tstepB + (size_t)nxt.k0 * 2 : cB;
        const int nt = cur.nt;
        for (int t = 0; t < nt; t += 2) {
            const bool last = (t == nt - 2);
            const char* a1 = cA + (size_t)(t + 1) * kstep;
            const char* a2 = last ? nA : cA + (size_t)(t + 2) * kstep; const char* b2 = last ? nB : cB + (size_t)(t + 2) * kstep;
            const char* a3 = a2 + kstep; const char* b3 = b2 + kstep;
            PG8_LDB(B0, 0, 0); PG8_LDB(B1, 0, 1); PG8_SCHED; PG8_LDA(At, 0, 0); PG8_STAGEA(PG8_SA(1, 1), a1 + hstepA, voffA);
            PG8_WAIT_V(8); PG8_WAIT_L(0); PG8_BAR; PG8_MMA(0, 0, At, B0); PG8_MMA(0, 1, At, B1); PG8_BAR; PG8_SCHED;
            PG8_LDA(At, 0, 1); PG8_STAGE(PG8_SB(0, 0), b2, voffB); PG8_STAGE(PG8_SB(0, 1), b2 + hstepB, voffB); PG8_STAGEA(PG8_SA(0, 0), a2, voffA);
            PG8_WAIT_V(8); PG8_WAIT_L(0); PG8_BAR; PG8_MMA(1, 0, At, B0); PG8_MMA(1, 1, At, B1); PG8_BAR; PG8_SCHED;
            PG8_LDB(B0, 1, 0); PG8_LDB(B1, 1, 1); PG8_SCHED; PG8_LDA(At, 1, 0); PG8_STAGEA(PG8_SA(0, 1), a2 + hstepA, voffA);
            PG8_WAIT_V(8); PG8_WAIT_L(0); PG8_BAR; PG8_MMA(0, 0, At, B0); PG8_MMA(0, 1, At, B1); PG8_BAR; PG8_SCHED;
            PG8_LDA(At, 1, 1); PG8_STAGE(PG8_SB(1, 0), b3, voffB); PG8_STAGE(PG8_SB(1, 1), b3 + hstepB, voffB); PG8_STAGEA(PG8_SA(1, 0), a3, voffA);
            PG8_WAIT_V(8); PG8_WAIT_L(0); PG8_BAR; PG8_MMA(1, 0, At, B0); PG8_MMA(1, 1, At, B1); PG8_BAR; PG8_SCHED;
        }
        if (wr == 0) PG8_BAR;
        E(acc, cur, wr, wc, fr, fq);
        if (!has_next) break;
#pragma unroll
        for (int a = 0; a < 2; ++a)
#pragma unroll
            for (int b = 0; b < 2; ++b)
#pragma unroll
                for (int m = 0; m < 4; ++m)
#pragma unroll
                    for (int n = 0; n < 2; ++n) acc[a][b][m][n] = (f32x4){0.f, 0.f, 0.f, 0.f};
        cur = nxt; cA = nA; cB = nB; ++ui;
        if (wr == 1) PG8_BAR;
    }
    PG8_WAIT_V(0);
    PG8_BAR;
#undef PG8_SA
#undef PG8_SB
#undef PG8_STAGE
#undef PG8_STAGEA
#undef PG8_LDA
#undef PG8_LDB
#undef PG8_MMA
#undef PG8_WAIT_V
#undef PG8_WAIT_L
#undef PG8_BAR
#undef PG8_SCHED
}

__device__ __forceinline__ u32x4 pack8(f32x4 v0, f32x4 v1) { u32x4 w; w.x = pk2(v0[0], v0[1]); w.y = pk2(v0[2], v0[3]); w.z = pk2(v1[0], v1[1]); w.w = pk2(v1[2], v1[3]); return w; }

struct EpiIn {
    static constexpr bool PERM = true;
    bf16_t* U2; bf16_t* PROJ;
    __device__ __forceinline__ void operator()(const f32x4 (&acc)[2][2][4][2], const Unit& u, int wr, int wc, int fr, int fq) const {
        const int row0 = u.pm * BM + wr * 64 + fr, colb = u.pn * BM + wc * 32 + 8 * fq;
#pragma unroll
        for (int ai = 0; ai < 2; ++ai)
#pragma unroll
            for (int m = 0; m < 4; ++m) { const int row = row0 + ai * HALF + m * 16;
#pragma unroll
                for (int bj = 0; bj < 2; ++bj) { const int col = colb + bj * HALF; const u32x4 w = pack8(acc[ai][bj][m][0], acc[ai][bj][m][1]);
                    bf16_t* dst;
                    if (u.pn < 2) dst = U2 + ((size_t)((col >> 4) * U2_ROWS + (row >> 6)) * U2_LD + (row & 63) * 16 + (col & 15));
                    else dst = PROJ + (size_t)row * NPJ + (col - 512);
                    *(u32x4*)dst = w; } }
    }
};
struct EpiRes {
    static constexpr bool PERM = true;
    XBuf xin, xout; const float* gate; int ntf; float* part;
    __device__ __forceinline__ void operator()(const f32x4 (&acc)[2][2][4][2], const Unit& u, int wr, int wc, int fr, int fq) const {
        const int row0 = u.pm * BM + wr * 64 + fr, col0 = u.pn * BM + wc * 32 + 8 * fq;
        if (u.nt != ntf) {
#pragma unroll
            for (int ai = 0; ai < 2; ++ai)
#pragma unroll
                for (int m = 0; m < 4; ++m)
#pragma unroll
                    for (int bj = 0; bj < 2; ++bj) { float* pp = part + ((size_t)u.tl * 256 + (wr * 64 + fr + ai * HALF + m * 16)) * 256 + wc * 32 + 8 * fq + bj * HALF;
                        *(f32x4*)pp = acc[ai][bj][m][0]; *(f32x4*)(pp + 4) = acc[ai][bj][m][1]; }
            return; }
#pragma unroll
        for (int ai = 0; ai < 2; ++ai) {
            const int bi = batch_of(row0 + ai * HALF);
            f32x4 gv[2][2];
#pragma unroll
            for (int bj = 0; bj < 2; ++bj)
#pragma unroll
                for (int n = 0; n < 2; ++n) gv[bj][n] = *(const f32x4*)(gate + (size_t)bi * NMOD + col0 + bj * HALF + n * 4);
#pragma unroll
            for (int m = 0; m < 4; ++m) { const int row = row0 + ai * HALF + m * 16;
                float xv[2][8];
#pragma unroll
                for (int bj = 0; bj < 2; ++bj) xload8(xin, row, col0 + bj * HALF, xv[bj]);
#pragma unroll
                for (int bj = 0; bj < 2; ++bj) { float o[8];
#pragma unroll
                    for (int j = 0; j < 4; ++j) { o[j] = xv[bj][j] + gv[bj][0][j] * acc[ai][bj][m][0][j]; o[4 + j] = xv[bj][4 + j] + gv[bj][1][j] * acc[ai][bj][m][1][j]; }
                    xstore8(xout, row, col0 + bj * HALF, o); }
                if (m & 1) asm volatile("" ::: "memory"); }
        }
    }
};
struct EpiFF1 {
    static constexpr bool PERM = true;
    bf16_t* O;
    __device__ __forceinline__ void operator()(const f32x4 (&acc)[2][2][4][2], const Unit& u, int wr, int wc, int fr, int fq) const {
        const int row0 = u.pm * BM + wr * 64 + fr, col0 = u.pn * BM + wc * 32 + 8 * fq;
#pragma unroll
        for (int ai = 0; ai < 2; ++ai)
#pragma unroll
            for (int m = 0; m < 4; ++m) { bf16_t* rowp = O + (size_t)(row0 + ai * HALF + m * 16) * DFF + col0;
#pragma unroll
                for (int bj = 0; bj < 2; ++bj) { f32x4 v0 = acc[ai][bj][m][0], v1 = acc[ai][bj][m][1];
#pragma unroll
                    for (int j = 0; j < 4; ++j) { const float a0 = fmaxf(v0[j], 0.f), a1 = fmaxf(v1[j], 0.f); v0[j] = a0 * a0; v1[j] = a1 * a1; }
                    __builtin_nontemporal_store(pack8(v0, v1), (u32x4*)(rowp + bj * HALF)); } }
    }
};
struct EpiS1 {
    static constexpr bool PERM = false;
    float* Eo;
    __device__ __forceinline__ void operator()(const f32x4 (&acc)[2][2][4][2], const Unit& u, int wr, int wc, int fr, int fq) const {
        const int row0 = u.pm * BM + wr * 64 + fr, col0 = wc * 32 + 4 * fq;
#pragma unroll
        for (int ai = 0; ai < 2; ++ai)
#pragma unroll
            for (int m = 0; m < 4; ++m) { float* rowp = Eo + (size_t)(row0 + ai * HALF + m * 16) * 256 + col0;
#pragma unroll
                for (int bj = 0; bj < 2; ++bj)
#pragma unroll
                    for (int n = 0; n < 2; ++n) *(f32x4*)(rowp + bj * HALF + n * 16) = acc[ai][bj][m][n]; }
    }
};
struct EpiS2 {
    static constexpr bool PERM = true;
    bf16_t* YG;
    __device__ __forceinline__ void operator()(const f32x4 (&acc)[2][2][4][2], const Unit& u, int wr, int wc, int fr, int fq) const {
        const int g = u.pm / 3, i3 = u.pm - 3 * g, j4 = u.pn & 3;
        const int cr0 = i3 * BM + wr * 64 + fr, cb = j4 * BM + wc * 32 + 8 * fq;
#pragma unroll
        for (int ai = 0; ai < 2; ++ai)
#pragma unroll
            for (int m = 0; m < 4; ++m) { const int cr = cr0 + ai * HALF + m * 16;
                if (cr < 544) {
#pragma unroll
                    for (int bj = 0; bj < 2; ++bj) { const int c = cb + bj * HALF; f32x4 v0 = acc[ai][bj][m][0], v1 = acc[ai][bj][m][1];
#pragma unroll
                        for (int j = 0; j < 4; ++j) { v0[j] = gelu_tanh(v0[j]); v1[j] = gelu_tanh(v1[j]); }
                        *(u32x4*)(YG + (size_t)(cr * 64 + (c >> 4)) * 512 + g * 16 + (c & 15)) = pack8(v0, v1); } } }
    }
};
struct EpiGlu2 {
    static constexpr bool PERM = true;
    const bf16_t* YG; bf16_t* YC; LAS float* rss;
    __device__ __forceinline__ void operator()(const f32x4 (&acc)[2][2][4][2], const Unit& u, int wr, int wc, int fr, int fq) const {
        const int col0 = u.pn * BM + wc * 32 + 8 * fq;
#pragma unroll
        for (int ai = 0; ai < 2; ++ai)
#pragma unroll
            for (int m = 0; m < 4; ++m) { const int rl = wr * 64 + fr + ai * HALF + m * 16; const size_t row = (size_t)u.pm * BM + rl; float part = 0.f;
#pragma unroll
                for (int bj = 0; bj < 2; ++bj) { const int col = col0 + bj * HALF; const u32x4 yw = *(const u32x4*)(YG + row * 512 + col); float y[8], o[8]; unpack8(yw, y);
                    const f32x4 v0 = acc[ai][bj][m][0], v1 = acc[ai][bj][m][1];
#pragma unroll
                    for (int j = 0; j < 4; ++j) { o[j] = y[j] / (1.0f + __expf(-v0[j])); o[4 + j] = y[4 + j] / (1.0f + __expf(-v1[j])); }
#pragma unroll
                    for (int j = 0; j < 8; ++j) part += o[j] * o[j];
                    u32x4 w; w.x = pk2(o[0], o[1]); w.y = pk2(o[2], o[3]); w.z = pk2(o[4], o[5]); w.w = pk2(o[6], o[7]);
                    *(u32x4*)(YC + row * D + col) = w; }
                part += __shfl_xor(part, 16); part += __shfl_xor(part, 32);
                if (fq == 0) (void)__hip_atomic_fetch_add(rss + rl, part, __ATOMIC_RELAXED, __HIP_MEMORY_SCOPE_WORKGROUP); }
    }
};
struct EpiGlu {
    static constexpr bool PERM = true;
    const bf16_t* YG; float* YT;
    __device__ __forceinline__ void operator()(const f32x4 (&acc)[2][2][4][2], const Unit& u, int wr, int wc, int fr, int fq) const {
        const int row0 = u.pm * BM + wr * 64 + fr, col0 = u.pn * BM + wc * 32 + 8 * fq;
#pragma unroll
        for (int ai = 0; ai < 2; ++ai)
#pragma unroll
            for (int m = 0; m < 4; ++m) { const size_t ro = (size_t)(row0 + ai * HALF + m * 16) * 512 + col0;
#pragma unroll
                for (int bj = 0; bj < 2; ++bj) { const u32x4 yw = *(const u32x4*)(YG + ro + bj * HALF); float y[8]; unpack8(yw, y);
                    const f32x4 v0 = acc[ai][bj][m][0], v1 = acc[ai][bj][m][1]; f32x4 o0, o1;
#pragma unroll
                    for (int j = 0; j < 4; ++j) { o0[j] = y[j] / (1.0f + __expf(-v0[j])); o1[j] = y[4 + j] / (1.0f + __expf(-v1[j])); }
                    *(f32x4*)(YT + ro + bj * HALF) = o0; *(f32x4*)(YT + ro + bj * HALF + 4) = o1; } }
    }
};
}

__device__ __forceinline__ double SC(double c) { asm volatile("" : "+s"(c)); return c; }
__device__ __forceinline__ double dexp_(double x) {
    const double n = __builtin_rint(x * SC(1.4426950408889634));
    const double r = (x - n * SC(0.693147180369123816490)) - n * SC(1.90821492927058770002e-10);
    double p = SC(1.0 / 6227020800.0);
    p = p * r + SC(1.0 / 479001600.0); p = p * r + SC(1.0 / 39916800.0); p = p * r + SC(1.0 / 3628800.0); p = p * r + SC(1.0 / 362880.0); p = p * r + SC(1.0 / 40320.0);
    p = p * r + SC(1.0 / 5040.0); p = p * r + SC(1.0 / 720.0); p = p * r + SC(1.0 / 120.0); p = p * r + SC(1.0 / 24.0); p = p * r + SC(1.0 / 6.0); p = p * r + SC(0.5); p = p * r + SC(1.0); p = p * r + SC(1.0);
    const long long e = (long long)(1023 + (int)n) << 52;
    return p * __builtin_bit_cast(double, e);
}
__device__ __forceinline__ void dsincos_(double x, double& s, double& c) {
    const double kf = __builtin_rint(x * SC(0.63661977236758134308));
    const double r = (x - kf * SC(1.57079632673412561417)) - kf * SC(6.07710050650619224932e-11);
    const double z = r * r;
    double ps = SC(1.0 / 355687428096000.0);
    ps = ps * z - SC(1.0 / 1307674368000.0); ps = ps * z + SC(1.0 / 6227020800.0); ps = ps * z - SC(1.0 / 39916800.0); ps = ps * z + SC(1.0 / 362880.0); ps = ps * z - SC(1.0 / 5040.0); ps = ps * z + SC(1.0 / 120.0); ps = ps * z - SC(1.0 / 6.0);
    const double sr = r + r * z * ps;
    double pc = -SC(1.0 / 6402373705728000.0);
    pc = pc * z + SC(1.0 / 20922789888000.0); pc = pc * z - SC(1.0 / 87178291200.0); pc = pc * z + SC(1.0 / 479001600.0); pc = pc * z - SC(1.0 / 3628800.0); pc = pc * z + SC(1.0 / 40320.0); pc = pc * z - SC(1.0 / 720.0); pc = pc * z + SC(1.0 / 24.0); pc = pc * z - SC(0.5);
    const double cr = SC(1.0) + z * pc;
    const int k = ((int)kf) & 3;
    s = (k == 0) ? sr : (k == 1) ? cr : (k == 2) ? -sr : -cr;
    c = (k == 0) ? cr : (k == 1) ? -sr : (k == 2) ? -cr : sr;
}

__device__ __forceinline__ void transpose_tile(const float* W, int K, int N, bf16_t* WT, LAS float* T_, int item, int lane, int wave) {
    const int nnb = N / 256, kb = item / nnb, nb = item % nnb, k0 = 128 * kb, n0 = 256 * nb;
    __syncthreads();
#pragma unroll 1
    for (int hb = 0; hb < 16; hb += 8) { float tv[8][4];
#pragma unroll
        for (int i = 0; i < 8; ++i)
#pragma unroll
            for (int j = 0; j < 4; ++j) tv[i][j] = __builtin_nontemporal_load(W + (size_t)(k0 + wave * 16 + hb + i) * N + n0 + lane + 64 * j);
#pragma unroll
        for (int i = 0; i < 8; ++i)
#pragma unroll
            for (int j = 0; j < 4; ++j) T_[(wave * 16 + hb + i) * 257 + lane + 64 * j] = tv[i][j]; }
    __syncthreads();
    const int c = lane & 15;
#pragma unroll
    for (int j = 0; j < 8; ++j) { const int n = (lane >> 4) + 4 * wave + 32 * j; const LAS float* s = T_ + (8 * c) * 257 + n;
        u32x4 o; o.x = pk2(s[0 * 257], s[1 * 257]); o.y = pk2(s[2 * 257], s[3 * 257]); o.z = pk2(s[4 * 257], s[5 * 257]); o.w = pk2(s[6 * 257], s[7 * 257]);
        *(u32x4*)(WT + (size_t)(n0 + n) * K + k0 + 8 * c) = o; }
}
__device__ __forceinline__ void transpose_weights(CArgs a, LAS unsigned char* lds, int lo, int hi, int lane, int wave, int wi, int nw) {
    LAS float* T_ = (LAS float*)lds;
    constexpr int I_IN = 16 * 13, I_OUT = 16 * 8, I_F1 = 16 * 32, I_F2 = 64 * 8, I_GL = 4 * 2, I_L = I_IN + I_OUT + I_F1 + I_F2 + I_GL;
    for (int it = lo + wi; it < hi; it += nw) {
        const int l = it / I_L; int r = it - l * I_L; unsigned char* wl = a->ws + WS_W + (size_t)l * WPL;
        if (r < I_IN) { transpose_tile(a->in[12] + (size_t)l * D * NIN, D, NIN, (bf16_t*)(wl + W_IN), T_, r, lane, wave); continue; } r -= I_IN;
        if (r < I_OUT) { transpose_tile(a->in[27] + (size_t)l * D * D, D, D, (bf16_t*)(wl + W_OUT), T_, r, lane, wave); continue; } r -= I_OUT;
        if (r < I_F1) { transpose_tile(a->in[28] + (size_t)l * D * DFF, D, DFF, (bf16_t*)(wl + W_FF1), T_, r, lane, wave); continue; } r -= I_F1;
        if (r < I_F2) { transpose_tile(a->in[29] + (size_t)l * DFF * D, DFF, D, (bf16_t*)(wl + W_FF2), T_, r, lane, wave); continue; } r -= I_F2;
        transpose_tile(a->in[21] + (size_t)l * 512 * 512, 512, 512, (bf16_t*)(wl + W_GLU), T_, r, lane, wave);
    }
    __syncthreads();
}
constexpr int TR_ITEMS = 2 * (16 * 13 + 16 * 8 + 16 * 32 + 64 * 8 + 4 * 2);

__device__ __forceinline__ void phase0(CArgs a, LAS unsigned char* lds, int tid, int lane, int wave, int G, int bx) {
    unsigned char* ws = a->ws;
    for (int it = bx; it < 192; it += G) {
        const int l = it / 96, cb = it % 96;
        LAS float* S = (LAS float*)lds;
        f32x2 acc[NB];
#pragma unroll
        for (int r = 0; r < NB; ++r) acc[r] = (f32x2){0.f, 0.f};
        const float* Wl = a->in[10] + (size_t)l * D * NMOD + cb * 128 + lane * 2;
        for (int half = 0; half < 2; ++half) {
            __syncthreads();
            for (int idx = tid; idx < NB * 1024; idx += 512) { const int r = idx >> 10, k = idx & 1023;
                const float c = r < 2 ? a->in[7][r * D + half * 1024 + k] : a->in[8][(r - 2) * D + half * 1024 + k];
                S[idx] = c / (1.0f + __expf(-c)); }
            __syncthreads();
            const int kb = wave * 128;
            for (int kk = 0; kk < 128; kk += 16) {
                const int k = kb + kk; const float* wp = Wl + (size_t)(half * 1024 + k) * NMOD;
                f32x2 wv[16];
#pragma unroll
                for (int i = 0; i < 16; ++i) wv[i] = __builtin_nontemporal_load((const f32x2*)(wp + (size_t)i * NMOD));
#pragma unroll
                for (int q = 0; q < 4; ++q) {
#pragma unroll
                    for (int r = 0; r < NB; ++r) { const f32x4 s4 = *(const LAS f32x4*)(S + r * 1024 + k + 4 * q);
                        acc[r] += wv[4 * q] * s4[0]; acc[r] += wv[4 * q + 1] * s4[1]; acc[r] += wv[4 * q + 2] * s4[2]; acc[r] += wv[4 * q + 3] * s4[3]; } }
            }
        }
        __syncthreads();
#pragma unroll
        for (int r = 0; r < NB; ++r) *(LAS f32x2*)(S + (wave * NB + r) * 128 + lane * 2) = acc[r];
        __syncthreads();
        float* MOD = (float*)(ws + WS_MOD);
        for (int idx = tid; idx < NB * 128; idx += 512) { const int r = idx >> 7, col = idx & 127; float s = a->in[11][l * NMOD + cb * 128 + col];
#pragma unroll
            for (int w = 0; w < 8; ++w) s += S[(w * NB + r) * 128 + col];
            MOD[(size_t)(l * NB + r) * NMOD + cb * 128 + col] = s; }
        __syncthreads();
    }
    if (bx == G - 1) {
        float* BL = (float*)(ws + WS_BIAS);
        for (int idx = tid; idx < 4096; idx += 512) { const int h = idx >> 8, ri = idx & 255; const int rel = ri - 191; const int n = rel < 0 ? -rel : rel;
            int bk; if (n < 8) bk = n; else { int far = 8 + (int)(logf((float)n * 0.125f) / 2.0794415416798357f * 8.0f); bk = far < 15 ? far : 15; }
            if (rel > 0) bk += 16;
            BL[idx] = a->in[9][bk * 16 + h]; }
    }
    __syncthreads();
    transpose_weights(a, lds, 0, G == 256 ? TR_ITEMS / 2 : TR_ITEMS, lane, wave, bx, G);
}

__device__ __forceinline__ void rownorm_phase(const XBuf xin, const float* mod_shift, const float* mod_scale, bf16_t* XN, int lane, int gw, int NGW) {
    for (int row0 = gw * 2; row0 < T; row0 += NGW * 2) {
        const int bi = batch_of(row0);
        float v[2][4][8]; float ss0 = 0.f, ss1 = 0.f;
#pragma unroll
        for (int j = 0; j < 4; ++j) { xload8(xin, row0, 8 * lane + 512 * j, v[0][j]); xload8(xin, row0 + 1, 8 * lane + 512 * j, v[1][j]); }
#pragma unroll
        for (int j = 0; j < 4; ++j)
#pragma unroll
            for (int k = 0; k < 8; ++k) { ss0 += v[0][j][k] * v[0][j][k]; ss1 += v[1][j][k] * v[1][j][k]; }
        const float rs0 = rsqrtf(wave_sum(ss0) * (1.0f / D) + EPS), rs1 = rsqrtf(wave_sum(ss1) * (1.0f / D) + EPS);
        const float* sh = mod_shift + (size_t)bi * NMOD; const float* sc = mod_scale + (size_t)bi * NMOD;
#pragma unroll
        for (int j = 0; j < 4; ++j) { const int c = 8 * lane + 512 * j;
            const f32x4 s0 = 1.0f + *(const f32x4*)(sc + c), s1 = 1.0f + *(const f32x4*)(sc + c + 4), h0 = *(const f32x4*)(sh + c), h1 = *(const f32x4*)(sh + c + 4);
            u32x4 w0, w1;
            w0.x = pk2(v[0][j][0] * rs0 * s0[0] + h0[0], v[0][j][1] * rs0 * s0[1] + h0[1]); w0.y = pk2(v[0][j][2] * rs0 * s0[2] + h0[2], v[0][j][3] * rs0 * s0[3] + h0[3]);
            w0.z = pk2(v[0][j][4] * rs0 * s1[0] + h1[0], v[0][j][5] * rs0 * s1[1] + h1[1]); w0.w = pk2(v[0][j][6] * rs0 * s1[2] + h1[2], v[0][j][7] * rs0 * s1[3] + h1[3]);
            w1.x = pk2(v[1][j][0] * rs1 * s0[0] + h0[0], v[1][j][1] * rs1 * s0[1] + h0[1]); w1.y = pk2(v[1][j][2] * rs1 * s0[2] + h0[2], v[1][j][3] * rs1 * s0[3] + h0[3]);
            w1.z = pk2(v[1][j][4] * rs1 * s1[0] + h1[0], v[1][j][5] * rs1 * s1[1] + h1[1]); w1.w = pk2(v[1][j][6] * rs1 * s1[2] + h1[2], v[1][j][7] * rs1 * s1[3] + h1[3]);
            *(u32x4*)(XN + (size_t)row0 * D + c) = w0; *(u32x4*)(XN + (size_t)(row0 + 1) * D + c) = w1; }
    }
}

__device__ __forceinline__ void ssm_build(CArgs a, int l, LAS unsigned char* lds, int tid, int G, int bx) {
    LAS float* PR = (LAS float*)lds;
    LAS float* PI = PR + 64 * 65;
    LAS float* WR = PI + 64 * 65;
    LAS float* WI = WR + 1024;
    LAS float* CC = WI + 1024;
    LAS float* KT = CC + 2048;
    bf16_t* MT = (bf16_t*)(a->ws + WS_MT); bf16_t* EM = (bf16_t*)(a->ws + WS_EM); float* A64 = (float*)(a->ws + WS_A64);
    for (int it = bx; it < 256; it += G) {
        const int g = it >> 3, part = it & 7;
        __syncthreads();
        if (tid < 64) { const int p = tid;
            const double dt = dexp_((double)a->in[15][l * 32 + g]);
            const double ar = (double)a->in[13][(l * 32 + g) * 64 + p], ai = (double)a->in[14][(l * 32 + g) * 64 + p];
            const double mag = dexp_(dt * ar); double sn, cs; dsincos_(dt * ai, sn, cs);
            const double abr = mag * cs, abi = mag * sn, den = ar * ar + ai * ai;
            const double fr = ((abr - 1.0) * ar + abi * ai) / den, fi = (abi * ar - (abr - 1.0) * ai) / den;
            double pr = 1.0, pi = 0.0;
            for (int j = 0; j <= 64; ++j) { PR[p * 65 + j] = (float)pr; PI[p * 65 + j] = (float)pi; const double nr = pr * abr - pi * abi, ni = pr * abi + pi * abr; pr = nr; pi = ni; }
            if (part == 0) { A64[(g * 64 + p) * 2] = PR[p * 65 + 64]; A64[(g * 64 + p) * 2 + 1] = PI[p * 65 + 64]; }
            for (int hi = 0; hi < 16; ++hi) { const double br = (double)a->in[16][((size_t)(l * 32 + g) * 64 + p) * 16 + hi], bi = (double)a->in[17][((size_t)(l * 32 + g) * 64 + p) * 16 + hi];
                WR[p * 16 + hi] = (float)(fr * br - fi * bi); WI[p * 16 + hi] = (float)(fr * bi + fi * br); }
        }
        for (int idx = tid; idx < 1024; idx += 512) { const int ho = idx >> 6, p = idx & 63; CC[p * 32 + ho * 2] = a->in[18][(size_t)(l * 32 + g) * 1024 + idx]; CC[p * 32 + ho * 2 + 1] = a->in[19][(size_t)(l * 32 + g) * 1024 + idx]; }
        __syncthreads();
#pragma unroll 1
        for (int r = 0; r < 2; ++r) { const int idx = tid + 512 * r, j = idx >> 4, hi = idx & 15; float acc[16];
#pragma unroll
            for (int ho = 0; ho < 16; ++ho) acc[ho] = 0.f;
#pragma unroll 2
            for (int p = 0; p < 64; ++p) { const float pr = PR[p * 65 + j], pi = PI[p * 65 + j], wr = WR[p * 16 + hi], wi = WI[p * 16 + hi];
                const float tr = pr * wr - pi * wi, ti = pr * wi + pi * wr;
#pragma unroll
                for (int q = 0; q < 8; ++q) { const f32x4 c4 = *(const LAS f32x4*)(CC + p * 32 + q * 4); acc[2 * q] += c4[0] * tr - c4[1] * ti; acc[2 * q + 1] += c4[2] * tr - c4[3] * ti; } }
#pragma unroll
            for (int ho = 0; ho < 16; ++ho) KT[j * 256 + ho * 16 + hi] = acc[ho]; }
        __syncthreads();
        for (int pc = tid; pc < 128 * 160; pc += 512) { const int rl = pc / 160, c8 = pc % 160; const int t = 8 * part + (rl >> 4), ho = rl & 15; const int c0 = c8 * 8; float v[8];
            if (c0 < 1024) { const int s = c0 >> 4, hi0 = c0 & 15;
                if (t >= s) { const f32x4 k0 = *(const LAS f32x4*)(KT + (t - s) * 256 + ho * 16 + hi0), k1 = *(const LAS f32x4*)(KT + (t - s) * 256 + ho * 16 + hi0 + 4);
#pragma unroll
                    for (int k = 0; k < 4; ++k) { v[k] = k0[k]; v[4 + k] = k1[k]; }
                    if (t == s && (ho >> 3) == (hi0 >> 3)) { const float dsk = a->in[20][l * 512 + g * 16 + ho];
#pragma unroll
                        for (int k = 0; k < 8; ++k) v[k] += (hi0 + k == ho) ? dsk : 0.f; }
                } else {
#pragma unroll
                    for (int k = 0; k < 8; ++k) v[k] = 0.f; }
            } else { const int cc = (c0 - 1024) & 127;
#pragma unroll
                for (int k = 0; k < 8; ++k) { const int col = cc + k, ri = col >> 6, p = col & 63; const float pr = PR[p * 65 + t + 1], pi = PI[p * 65 + t + 1], cr = CC[p * 32 + ho * 2], ci = CC[p * 32 + ho * 2 + 1];
                    v[k] = ri == 0 ? (cr * pr - ci * pi) : -(cr * pi + ci * pr); }
            }
            u32x4 w; w.x = pk2(v[0], v[1]); w.y = pk2(v[2], v[3]); w.z = pk2(v[4], v[5]); w.w = pk2(v[6], v[7]);
            *(u32x4*)(MT + ((size_t)(g * 1024 + t * 16 + ho)) * U2_LD + c0) = w; }
        for (int pc = tid; pc < 32 * 128; pc += 512) { const int row = 32 * part + (pc >> 7), c0 = (pc & 127) * 8; float v[8];
            if (row < 128) { const int ri = row >> 6, p = row & 63, s = c0 >> 4, hi0 = c0 & 15; const float pr = PR[p * 65 + 63 - s], pi = PI[p * 65 + 63 - s];
#pragma unroll
                for (int k = 0; k < 8; ++k) { const float wr = WR[p * 16 + hi0 + k], wi = WI[p * 16 + hi0 + k]; v[k] = ri == 0 ? (pr * wr - pi * wi) : (pr * wi + pi * wr); }
            } else {
#pragma unroll
                for (int k = 0; k < 8; ++k) v[k] = 0.f; }
            u32x4 w; w.x = pk2(v[0], v[1]); w.y = pk2(v[2], v[3]); w.z = pk2(v[4], v[5]); w.w = pk2(v[6], v[7]);
            *(u32x4*)(EM + ((size_t)(g * 256 + row)) * 1024 + c0) = w; }
    }
    __syncthreads();
}

__device__ __forceinline__ void put_hin(bf16_t* U2, int g, int cr, int p, float hr, float hi) {
    bf16_t* d = U2 + (size_t)(g * U2_ROWS + cr) * U2_LD + 1024 + p;
    const unsigned rh = f2bf(hr), ih = f2bf(hi);
    const float rl = hr - __builtin_bit_cast(float, rh << 16), il = hi - __builtin_bit_cast(float, ih << 16);
    d[0] = (bf16_t)rh; d[64] = (bf16_t)ih; d[128] = (bf16_t)f2bf(rl); d[192] = (bf16_t)f2bf(il);
}
__device__ __forceinline__ void carry_phase(CArgs a, int l, LAS unsigned char* lds, int tid, int lane, int wave, int G, int bx) {
    bf16_t* U2 = (bf16_t*)(a->ws + WS_U2); const float* E = (const float*)(a->ws + WS_E); const float* A64 = (const float*)(a->ws + WS_A64);
    LAS float* SE = (LAS float*)lds;
    for (int it = bx; it < 192; it += G) {
        if (it < 64) {
            const int b = it >> 5, g = it & 31, p = lane, seg = wave;
            const float ar = A64[(g * 64 + p) * 2], ai = A64[(g * 64 + p) * 2 + 1];
            float er[32], ei[32];
#pragma unroll
            for (int k = 0; k < 32; ++k) { const size_t ro = (size_t)(g * U2_ROWS + b * 256 + seg * 32 + k) * 256; er[k] = E[ro + p]; ei[k] = E[ro + 64 + p]; }
            float hr = 0.f, hi = 0.f;
#pragma unroll
            for (int k = 0; k < 32; ++k) { const float nr = ar * hr - ai * hi + er[k], ni = ar * hi + ai * hr + ei[k]; hr = nr; hi = ni; }
            __syncthreads();
            SE[(seg * 64 + p) * 2] = hr; SE[(seg * 64 + p) * 2 + 1] = hi;
            __syncthreads();
            float br = ar, bi = ai;
#pragma unroll
            for (int q = 0; q < 5; ++q) { const float nr = br * br - bi * bi, ni = 2.f * br * bi; br = nr; bi = ni; }
            float cr_ = 0.f, ci_ = 0.f;
            for (int s2 = 0; s2 < seg; ++s2) { const float sr = SE[(s2 * 64 + p) * 2], si = SE[(s2 * 64 + p) * 2 + 1]; const float nr = br * cr_ - bi * ci_ + sr, ni = br * ci_ + bi * cr_ + si; cr_ = nr; ci_ = ni; }
            hr = cr_; hi = ci_;
#pragma unroll
            for (int k = 0; k < 32; ++k) { put_hin(U2, g, b * 256 + seg * 32 + k, p, hr, hi);
                const float nr = ar * hr - ai * hi + er[k], ni = ar * hi + ai * hr + ei[k]; hr = nr; hi = ni; }
            if (seg == 7) { a->out[O_SRP + (size_t)((l * 2 + b) * 32 + g) * 64 + p] = hr; a->out[O_SIP + (size_t)((l * 2 + b) * 32 + g) * 64 + p] = hi; }
        } else {
            const int idx = it - 64, sb = idx >> 2, g = (idx & 3) * 8 + wave, p = lane;
            const float ar = A64[(g * 64 + p) * 2], ai = A64[(g * 64 + p) * 2 + 1];
            const size_t so = (size_t)((l * 32 + sb) * 32 + g) * 64 + p;
            const float hr = a->in[4][so], hi = a->in[5][so];
            put_hin(U2, g, 512 + sb, p, hr, hi);
            const size_t ro = (size_t)(g * U2_ROWS + 512 + sb) * 256;
            a->out[O_SRS + so] = ar * hr - ai * hi + E[ro + p]; a->out[O_SIS + so] = ar * hi + ai * hr + E[ro + 64 + p];
        }
    }
    __syncthreads();
}

__device__ __forceinline__ void conv_phase(CArgs a, int l, int lane, int gw, int NGW) {
    const bf16_t* PROJ = (const bf16_t*)(a->ws + WS_PROJ); bf16_t* YC = (bf16_t*)(a->ws + WS_XN);
    const int ch = lane * 8;
    float w0[8], w1[8], w2[8], og[8];
#pragma unroll
    for (int k = 0; k < 8; ++k) { const float* cw = a->in[25] + (size_t)(l * 512 + ch + k) * 3; w0[k] = cw[0]; w1[k] = cw[1]; w2[k] = cw[2]; og[k] = a->in[26][l * D + 1536 + ch + k]; }
#pragma unroll 2
    for (int tok = gw; tok < T; tok += NGW) {
        const bool pr = tok < TP; const int tl = pr ? (tok & (SEQ - 1)) : ((tok - TP) & 63); const int sb = pr ? 0 : ((tok - TP) >> 6);
        float z[3][8];
#pragma unroll
        for (int k = 0; k < 3; ++k) {
            if (tl - k >= 0) { const bf16_t* r = PROJ + (size_t)(tok - k) * NPJ; float gc[8], xc[8]; unpack8(*(const u32x4*)(r + PJ_GC + ch), gc); unpack8(*(const u32x4*)(r + PJ_XC + ch), xc);
#pragma unroll
                for (int j = 0; j < 8; ++j) z[k][j] = gc[j] * xc[j];
            } else if (pr) {
#pragma unroll
                for (int j = 0; j < 8; ++j) z[k][j] = 0.f;
            } else { const float* cb = a->in[6] + (size_t)((l * 32 + sb) * 2 + (tl - k + 2)) * 512 + ch; const f32x4 c0 = *(const f32x4*)cb, c1 = *(const f32x4*)(cb + 4);
#pragma unroll
                for (int j = 0; j < 4; ++j) { z[k][j] = c0[j]; z[k][4 + j] = c1[j]; } }
        }
        float gb[8]; unpack8(*(const u32x4*)(PROJ + (size_t)tok * NPJ + PJ_GB + ch), gb);
        float y[8], ss = 0.f;
#pragma unroll
        for (int j = 0; j < 8; ++j) { y[j] = gb[j] * (w0[j] * z[2][j] + w1[j] * z[1][j] + w2[j] * z[0][j]); ss += y[j] * y[j]; }
        const float rs = rsqrtf(wave_sum(ss) * (1.0f / 512.0f) + EPS);
        u32x4 w; w.x = pk2(y[0] * rs * og[0], y[1] * rs * og[1]); w.y = pk2(y[2] * rs * og[2], y[3] * rs * og[3]); w.z = pk2(y[4] * rs * og[4], y[5] * rs * og[5]); w.w = pk2(y[6] * rs * og[6], y[7] * rs * og[7]);
        *(u32x4*)(YC + (size_t)tok * D + 1536 + ch) = w;
        const int last = pr ? SEQ - 2 : 62;
        if (tl >= last) { float* dst = pr ? a->out + O_NCP + (size_t)((l * 2 + (tok >> 14)) * 2 + (tl - last)) * 512 + ch : a->out + O_NCS + (size_t)((l * 32 + sb) * 2 + (tl - last)) * 512 + ch;
            *(f32x4*)dst = (f32x4){z[0][0], z[0][1], z[0][2], z[0][3]}; *(f32x4*)(dst + 4) = (f32x4){z[0][4], z[0][5], z[0][6], z[0][7]}; }
    }
}
__device__ __forceinline__ void ssmnorm_phase(CArgs a, int l, int lane, int gw, int NGW) {
    const float* YT = (const float*)(a->ws + WS_YT); bf16_t* YC = (bf16_t*)(a->ws + WS_XN);
    const int ch = lane * 8; const f32x4 g0 = *(const f32x4*)(a->in[26] + l * D + ch), g1 = *(const f32x4*)(a->in[26] + l * D + ch + 4);
#pragma unroll 2
    for (int tok = gw; tok < T; tok += NGW) {
        const f32x4 v0 = *(const f32x4*)(YT + (size_t)tok * 512 + ch), v1 = *(const f32x4*)(YT + (size_t)tok * 512 + ch + 4);
        float ss = (v0[0] * v0[0] + v0[1] * v0[1]) + (v0[2] * v0[2] + v0[3] * v0[3]) + (v1[0] * v1[0] + v1[1] * v1[1]) + (v1[2] * v1[2] + v1[3] * v1[3]);
        const float rs = rsqrtf(wave_sum(ss) * (1.0f / 512.0f) + EPS);
        const f32x4 o0 = v0 * rs * g0, o1 = v1 * rs * g1;
        u32x4 w; w.x = pk2(o0[0], o0[1]); w.y = pk2(o0[2], o0[3]); w.z = pk2(o1[0], o1[1]); w.w = pk2(o1[2], o1[3]);
        *(u32x4*)(YC + (size_t)tok * D + ch) = w;
    }
}

constexpr int AT_KS = 0, AT_VT = 55296, AT_BL = 106496, AT_RED = 122880;
__device__ __forceinline__ int crow(int r, int h) { return (r & 3) + 8 * (r >> 2) + 4 * h; }
__device__ __forceinline__ void attn_phase(CArgs a, int l, LAS unsigned char* lds, int tid, int lane, int wave, int G, int bx) {
    const bf16_t* PROJ = (const bf16_t*)(a->ws + WS_PROJ); bf16_t* YC = (bf16_t*)(a->ws + WS_XN);
    LAS bf16_t* Ks = (LAS bf16_t*)(lds + AT_KS);
    LAS bf16_t* Vt = (LAS bf16_t*)(lds + AT_VT);
    LAS float* BL = (LAS float*)(lds + AT_BL);
    LAS float* RED = (LAS float*)(lds + AT_RED);
    const float* BLg = (const float*)(a->ws + WS_BIAS);
    for (int idx = tid; idx < 4096; idx += 512) BL[idx] = BLg[idx];
    const int ql = lane & 31, hf = lane >> 5;
    for (int it = (bx + 64) % G; it < 1088; it += G) {
        int ll = l; asm volatile("" : "+s"(ll));
        const bool pr = it < 1024; const int half = it & 1;
        const int bc = pr ? (it >> 1) : 0, c = bc & 255, b = bc >> 8, sb = pr ? 0 : ((it - 1024) >> 1);
        const int token0 = (pr ? bc * 64 : TP + sb * 64) + half * 32;
        __syncthreads();
        u32x4 rk[3][2], rv[3][2];
#pragma unroll
        for (int pass = 0; pass < 3; ++pass) {
            const int idx = tid + 512 * pass, row = idx >> 2, qd = idx & 3, kvh = row >= 192 ? 1 : 0, s = row - 192 * kvh, d0 = qd * 16;
            if (pr) { if ((c * 64 - 128 + s) >= 0) { const bf16_t* r = PROJ + (size_t)(bc * 64 - 128 + s) * NPJ;
                    rk[pass][0] = *(const u32x4*)(r + PJ_K + kvh * 64 + d0); rk[pass][1] = *(const u32x4*)(r + PJ_K + kvh * 64 + d0 + 8);
                    rv[pass][0] = *(const u32x4*)(r + PJ_V + kvh * 64 + d0); rv[pass][1] = *(const u32x4*)(r + PJ_V + kvh * 64 + d0 + 8); } }
            else if (s >= 128) { const bf16_t* r = PROJ + (size_t)(TP + sb * 64 + (s - 128)) * NPJ;
                rk[pass][0] = *(const u32x4*)(r + PJ_K + kvh * 64 + d0); rk[pass][1] = *(const u32x4*)(r + PJ_K + kvh * 64 + d0 + 8);
                rv[pass][0] = *(const u32x4*)(r + PJ_V + kvh * 64 + d0); rv[pass][1] = *(const u32x4*)(r + PJ_V + kvh * 64 + d0 + 8); }
        }
#pragma unroll
        for (int pass = 0; pass < 3; ++pass) {
            const int idx = tid + 512 * pass, row = idx >> 2, qd = idx & 3, kvh = row >= 192 ? 1 : 0, s = row - 192 * kvh, d0 = qd * 16;
            float kv[16], vv[16]; bool fromproj = false;
            if (pr) fromproj = (c * 64 - 128 + s) >= 0; else fromproj = s >= 128;
            if (fromproj) { unpack8(rk[pass][0], kv); unpack8(rk[pass][1], kv + 8); unpack8(rv[pass][0], vv); unpack8(rv[pass][1], vv + 8); }
            else if (!pr) { const size_t co = ((size_t)((ll * 32 + sb) * 128 + s) * 2 + kvh) * 64 + d0;
#pragma unroll
                for (int q = 0; q < 4; ++q) { const f32x4 k4 = *(const f32x4*)(a->in[2] + co + 4 * q), v4 = *(const f32x4*)(a->in[3] + co + 4 * q);
#pragma unroll
                    for (int j = 0; j < 4; ++j) { kv[4 * q + j] = k4[j]; vv[4 * q + j] = v4[j]; } }
            } else {
#pragma unroll
                for (int j = 0; j < 16; ++j) { kv[j] = 0.f; vv[j] = 0.f; } }
            float ss = 0.f;
#pragma unroll
            for (int j = 0; j < 16; ++j) ss += kv[j] * kv[j];
            ss += __shfl_xor(ss, 1); ss += __shfl_xor(ss, 2);
            if (fromproj) { const float rs = rsqrtf(ss * (1.0f / 64.0f) + EPS);
#pragma unroll
                for (int j = 0; j < 16; ++j) kv[j] = kv[j] * rs * a->in[23][ll * 64 + d0 + j]; }
            LAS bf16_t* kd = Ks + (kvh * 192 + s) * 72 + d0;
            u32x4 w0, w1; w0.x = pk2(kv[0], kv[1]); w0.y = pk2(kv[2], kv[3]); w0.z = pk2(kv[4], kv[5]); w0.w = pk2(kv[6], kv[7]);
            w1.x = pk2(kv[8], kv[9]); w1.y = pk2(kv[10], kv[11]); w1.z = pk2(kv[12], kv[13]); w1.w = pk2(kv[14], kv[15]);
            *(LAS u32x4*)kd = w0; *(LAS u32x4*)(kd + 8) = w1;
#pragma unroll
            for (int j = 0; j < 16; j += 2) { const unsigned pv = pk2(vv[j], vv[j + 1]); Vt[(kvh * 64 + d0 + j) * 200 + s] = (bf16_t)(pv & 0xffffu); Vt[(kvh * 64 + d0 + j + 1) * 200 + s] = (bf16_t)(pv >> 16); }
            int wrow = -1; float* nk = nullptr; float* nv = nullptr;
            if (half == 0) {
                if (pr) { if (c >= 254 && s >= 128) { wrow = (c - 254) * 64 + (s - 128); nk = a->out + O_NKP + (size_t)(l * 2 + b) * 128 * 128; nv = a->out + O_NVP + (size_t)(l * 2 + b) * 128 * 128; } }
                else if (s >= 64) { wrow = s - 64; nk = a->out + O_NKS + (size_t)(l * 32 + sb) * 128 * 128; nv = a->out + O_NVS + (size_t)(l * 32 + sb) * 128 * 128; }
            }
            if (wrow >= 0) { const size_t o = (size_t)wrow * 128 + kvh * 64 + d0;
#pragma unroll
                for (int q = 0; q < 4; ++q) { *(f32x4*)(nk + o + 4 * q) = (f32x4){kv[4 * q], kv[4 * q + 1], kv[4 * q + 2], kv[4 * q + 3]}; *(f32x4*)(nv + o + 4 * q) = (f32x4){vv[4 * q], vv[4 * q + 1], vv[4 * q + 2], vv[4 * q + 3]}; } }
        }
        const int kvh = wave >> 2, qtok = token0 + ql, qi = half * 32 + ql;
        u32x4 qraw[4];
#pragma unroll
        for (int st = 0; st < 4; ++st) qraw[st] = *(const u32x4*)(PROJ + (size_t)qtok * NPJ + (2 * wave) * 64 + st * 16 + hf * 8);
        __syncthreads();
        const int nmask = (pr && c < 2) ? 128 - 64 * c : 0;
        float ssq = 0.f;
#pragma unroll 1
        for (int hh = 0; hh < 2; ++hh) {
            const int h = 2 * wave + hh;
            bf16x8 qf[4];
            { float qv[4][8]; float ss = 0.f;
#pragma unroll
                for (int st = 0; st < 4; ++st) unpack8(qraw[st], qv[st]);
                if (hh == 0) {
#pragma unroll
                    for (int st = 0; st < 4; ++st) qraw[st] = *(const u32x4*)(PROJ + (size_t)qtok * NPJ + (h + 1) * 64 + st * 16 + hf * 8); }
#pragma unroll
                for (int st = 0; st < 4; ++st) {
#pragma unroll
                    for (int j = 0; j < 8; ++j) ss += qv[st][j] * qv[st][j]; }
                ss += __shfl_xor(ss, 32);
                const float rs = rsqrtf(ss * (1.0f / 64.0f) + EPS) * 0.125f;
#pragma unroll
                for (int st = 0; st < 4; ++st) { const float* qg = a->in[22] + ll * 64 + st * 16 + hf * 8; u32x4 w;
                    w.x = pk2(qv[st][0] * rs * qg[0], qv[st][1] * rs * qg[1]); w.y = pk2(qv[st][2] * rs * qg[2], qv[st][3] * rs * qg[3]);
                    w.z = pk2(qv[st][4] * rs * qg[4], qv[st][5] * rs * qg[5]); w.w = pk2(qv[st][6] * rs * qg[6], qv[st][7] * rs * qg[7]);
                    qf[st] = __builtin_bit_cast(bf16x8, w); } }
            const float sink = a->in[24][ll * 16 + h]; float mx = sink, sum = 0.f;
            const LAS float* blh = BL + h * 256 + 63 - qi;
            f32x16 o0, o1;
#pragma unroll
            for (int i = 0; i < 16; ++i) { o0[i] = 0.f; o1[i] = 0.f; }
#pragma unroll
            for (int ps = 0; ps < 6; ++ps) {
                asm volatile("" ::: "memory");
                float sv[1][16];
#pragma unroll
                for (int t3 = 0; t3 < 1; ++t3) { const int tt = ps + t3; f32x16 sa;
#pragma unroll
                    for (int i = 0; i < 16; ++i) sa[i] = 0.f;
#pragma unroll
                    for (int st = 0; st < 4; ++st) { const bf16x8 kf = *(const LAS bf16x8*)(Ks + (kvh * 192 + tt * 32 + ql) * 72 + st * 16 + hf * 8);
                        sa = __builtin_amdgcn_mfma_f32_32x32x16_bf16(kf, qf[st], sa, 0, 0, 0); }
#pragma unroll
                    for (int i = 0; i < 16; ++i) sv[t3][i] = sa[i]; }
                float mn = mx;
#pragma unroll
                for (int t3 = 0; t3 < 1; ++t3)
#pragma unroll
                    for (int i = 0; i < 16; ++i) { const int s = (ps + t3) * 32 + crow(i, hf); float v = sv[t3][i] + blh[s]; if (s < nmask) v = -1e30f; sv[t3][i] = v; mn = fmaxf(mn, v); }
                mn = fmaxf(mn, __shfl_xor(mn, 32));
                const float resc = __expf(mx - mn); mx = mn;
                float psum = 0.f;
#pragma unroll
                for (int t3 = 0; t3 < 1; ++t3)
#pragma unroll
                    for (int i = 0; i < 16; ++i) { const float p = __expf(sv[t3][i] - mx); sv[t3][i] = p; psum += p; }
                sum = sum * resc + psum;
                o0 = o0 * resc; o1 = o1 * resc;
#pragma unroll
                for (int t3 = 0; t3 < 1; ++t3)
#pragma unroll
                    for (int bb = 0; bb < 2; ++bb) { const int tt = ps + t3;
                        u32x4 pw; pw.x = pk2(sv[t3][8 * bb], sv[t3][8 * bb + 1]); pw.y = pk2(sv[t3][8 * bb + 2], sv[t3][8 * bb + 3]); pw.z = pk2(sv[t3][8 * bb + 4], sv[t3][8 * bb + 5]); pw.w = pk2(sv[t3][8 * bb + 6], sv[t3][8 * bb + 7]);
                        const bf16x8 pf = __builtin_bit_cast(bf16x8, pw);
                        const LAS bf16_t* v0p = Vt + (kvh * 64 + ql) * 200 + tt * 32 + 16 * bb + 4 * hf;
                        const LAS bf16_t* v1p = v0p + 32 * 200;
                        u32x4 a0, a1; { const u32x2 lo = *(const LAS u32x2*)v0p, hi = *(const LAS u32x2*)(v0p + 8); a0.x = lo.x; a0.y = lo.y; a0.z = hi.x; a0.w = hi.y; }
                        { const u32x2 lo = *(const LAS u32x2*)v1p, hi = *(const LAS u32x2*)(v1p + 8); a1.x = lo.x; a1.y = lo.y; a1.z = hi.x; a1.w = hi.y; }
                        o0 = __builtin_amdgcn_mfma_f32_32x32x16_bf16(__builtin_bit_cast(bf16x8, a0), pf, o0, 0, 0, 0);
                        o1 = __builtin_amdgcn_mfma_f32_32x32x16_bf16(__builtin_bit_cast(bf16x8, a1), pf, o1, 0, 0, 0);
                    }
            }
            sum += __shfl_xor(sum, 32);
            const float inv = 1.0f / (sum + __expf(sink - mx));
            o0 = o0 * inv; o1 = o1 * inv;
#pragma unroll
            for (int i = 0; i < 16; ++i) ssq += o0[i] * o0[i] + o1[i] * o1[i];
#pragma unroll
            for (int i4 = 0; i4 < 4; ++i4) { const int col = 512 + h * 64 + 8 * i4 + 4 * hf;
                u32x2 w; w.x = pk2(o0[4 * i4], o0[4 * i4 + 1]); w.y = pk2(o0[4 * i4 + 2], o0[4 * i4 + 3]); *(u32x2*)(YC + (size_t)qtok * D + col) = w;
                u32x2 w2; w2.x = pk2(o1[4 * i4], o1[4 * i4 + 1]); w2.y = pk2(o1[4 * i4 + 2], o1[4 * i4 + 3]); *(u32x2*)(YC + (size_t)qtok * D + col + 32) = w2; }
        }
        ssq += __shfl_xor(ssq, 32);
        if (lane < 32) RED[wave * 32 + ql] = ssq;
        asm volatile("s_waitcnt vmcnt(0)" ::: "memory");
        __syncthreads();
        float tot = 0.f;
#pragma unroll
        for (int w = 0; w < 8; ++w) tot += RED[w * 32 + ql];
        const float rs = rsqrtf(tot * (1.0f / 1024.0f) + EPS);
        { u32x2 yw[16]; bf16_t* yb = YC + (size_t)qtok * D + 512 + wave * 128 + 4 * hf;
#pragma unroll
          for (int k8 = 0; k8 < 16; ++k8) yw[k8] = *(const u32x2*)(yb + 8 * k8);
#pragma unroll
          for (int k8 = 0; k8 < 16; ++k8) { const f32x4 g4 = *(const f32x4*)(a->in[26] + ll * D + 512 + wave * 128 + 8 * k8 + 4 * hf);
              u32x2 w; w.x = pk2(bflo(yw[k8].x) * rs * g4[0], bfhi(yw[k8].x) * rs * g4[1]); w.y = pk2(bflo(yw[k8].y) * rs * g4[2], bfhi(yw[k8].y) * rs * g4[3]);
              *(u32x2*)(yb + 8 * k8) = w; } }
    }
    __syncthreads();
}


template <class Order>
__device__ __forceinline__ void reduce_tail(const Order& S, const float* PART, const float* gate, const XBuf xin, const XBuf xout, int lane, int wave, int G, int bx) {
    const int rows = 256 / S.split;
    for (int it = bx; it < (S.nwg - S.nfull) * S.split; it += G) { int pm, pn; S.tile_of(S.nfull + it / S.split, pm, pn);
        const int r0 = (it % S.split) * rows, c8 = (lane & 31) * 8;
        for (int rl = r0 + wave * 2 + (lane >> 5); rl < r0 + rows; rl += 16) { const int row = pm * 256 + rl, col = pn * 256 + c8;
            f32x4 s0 = {0.f, 0.f, 0.f, 0.f}, s1 = {0.f, 0.f, 0.f, 0.f};
            for (int p = 0; p < S.split; ++p) { const float* pp = PART + ((size_t)((it / S.split) * S.split + p) * 256 + rl) * 256 + c8; s0 += *(const f32x4*)pp; s1 += *(const f32x4*)(pp + 4); }
            const float* gp = gate + (size_t)batch_of(row) * NMOD + col; const f32x4 g0 = *(const f32x4*)gp, g1 = *(const f32x4*)(gp + 4);
            float xv[8], o[8]; xload8(xin, row, col, xv);
#pragma unroll
            for (int j = 0; j < 4; ++j) { o[j] = xv[j] + g0[j] * s0[j]; o[4 + j] = xv[4 + j] + g1[j] * s1[j]; }
            xstore8(xout, row, col, o); } }
}

#define XB_TMO      128
#define XB_XCNT(j)  (256  + 64 * (j))
#define XB_XSUB(j)  (1280 + 64 * (j))
#define XB_XGEN(j)  (2304 + 64 * (j))
#define XB_TOP      3328
#define XB_TOPGEN   3392
#define XCD_BAR_WORDS 3456
#define XB_SPIN_CAP (1u << 22)
__device__ __forceinline__ unsigned xb_ld(unsigned* p)              { return __hip_atomic_load(p, __ATOMIC_RELAXED, __HIP_MEMORY_SCOPE_AGENT); }
__device__ __forceinline__ unsigned xb_add(unsigned* p, unsigned v) { return __hip_atomic_fetch_add(p, v, __ATOMIC_RELAXED, __HIP_MEMORY_SCOPE_AGENT); }
__device__ __forceinline__ unsigned xb_xcc_id() { return (unsigned)__builtin_amdgcn_s_getreg((3 << 11) | 20) & 0xFu; }
#define XB_SPIN(cond, bar) do { unsigned _sp = 0; while (cond) { __builtin_amdgcn_s_sleep(1); \
    if ((++_sp & 255u) == 0u) { if (xb_ld(&(bar)[XB_TMO])) break; if (_sp > XB_SPIN_CAP) { atomicAdd(&(bar)[XB_TMO], 1u); break; } } } } while (0)
struct XcdBarrier { unsigned* bar; unsigned x; volatile LAS unsigned* st; };
__device__ __forceinline__ XcdBarrier xcd_barrier_post(unsigned* bar, volatile LAS unsigned* st) {
    XcdBarrier b; b.bar = bar; b.x = xb_xcc_id(); b.st = st;
    if (threadIdx.x == 0) (void)xb_add(&bar[XB_XCNT(b.x)], 1u);
    return b;
}
__device__ __forceinline__ void xcd_barrier_complete(unsigned* bar, unsigned x, unsigned& nloc, unsigned& nx) {
    const unsigned G = gridDim.x * gridDim.y * gridDim.z;
    unsigned sum, cnt, mine, sp = 0u;
    for (;;) {
        sum = 0u; cnt = 0u; mine = 0u;
#pragma unroll
        for (unsigned j = 0; j < 16; ++j) { const unsigned c = xb_ld(&bar[XB_XCNT(j)]); sum += c; cnt += (c > 0u) ? 1u : 0u; mine = (j == x) ? c : mine; }
        if (sum == G) break;
        __builtin_amdgcn_s_sleep(1);
        if ((++sp & 255u) == 0u) { if (xb_ld(&bar[XB_TMO])) break; if (sp > XB_SPIN_CAP) { atomicAdd(&bar[XB_TMO], 1u); break; } }
    }
    nloc = mine > 0u ? mine : 1u; nx = cnt > 0u ? cnt : 1u;
}
__device__ __forceinline__ void xcd_barrier(const XcdBarrier& b, const int tid) {
    asm volatile("s_waitcnt vmcnt(0)" ::: "memory");
    __syncthreads();
    if (tid == 0) {
        unsigned* bar = b.bar;
        __builtin_amdgcn_s_waitcnt(0);
        unsigned nloc = b.st[0], nx = b.st[1];
        if (nloc == 0u) { xcd_barrier_complete(bar, b.x, nloc, nx); b.st[0] = nloc; b.st[1] = nx; }
        const unsigned old = xb_add(&bar[XB_XSUB(b.x)], 1u);
        const unsigned gen = old / nloc;
        if (old + 1u == (gen + 1u) * nloc) {
            __builtin_amdgcn_fence(__ATOMIC_RELEASE, "agent");
            asm volatile("s_waitcnt vmcnt(0)" ::: "memory");
            const unsigned og = xb_add(&bar[XB_TOP], 1u);
            const unsigned tg = og / nx;
            if (og + 1u == (tg + 1u) * nx) xb_add(&bar[XB_TOPGEN], 1u);
            else XB_SPIN(xb_ld(&bar[XB_TOPGEN]) == tg, bar);
            __builtin_amdgcn_fence(__ATOMIC_ACQUIRE, "agent");
            xb_add(&bar[XB_XGEN(b.x)], 1u);
            asm volatile("s_waitcnt vmcnt(0)" ::: "memory");
        } else {
            XB_SPIN(xb_ld(&bar[XB_XGEN(b.x)]) == gen, bar);
            __builtin_amdgcn_fence(__ATOMIC_ACQUIRE, "agent");
            asm volatile("s_waitcnt vmcnt(0)" ::: "memory");
        }
    }
    __syncthreads();
}
constexpr int LDS_ST_OFF = LDS_BYTES - 64;

__global__ void __launch_bounds__(512, 2) mega(Args a_) {
    extern __shared__ __attribute__((aligned(16))) unsigned char lds_raw[];
    LAS unsigned char* lds = (LAS unsigned char*)lds_raw;
    cg::grid_group grid = cg::this_grid();
    const int ph_lo = a_.ph_lo, ph_hi = a_.ph_hi; int rep = 0; (void)rep;
    volatile LAS unsigned* bst = (volatile LAS unsigned*)(lds + LDS_ST_OFF);
    if (threadIdx.x < 2) bst[threadIdx.x] = 0u;
    __syncthreads();
    const XcdBarrier xbar = xcd_barrier_post((unsigned*)a_.ws, bst);
    const int wave0 = __builtin_amdgcn_readfirstlane((int)(threadIdx.x >> 6));
    for (int ph = ph_lo; ph < ph_hi; ++ph) {
        unsigned zz = 0u; asm volatile("" : "+v"(zz)); int w0 = wave0; asm volatile("" : "+s"(w0));
        int tid = w0 * 64 + (int)__builtin_amdgcn_mbcnt_hi(~0u, __builtin_amdgcn_mbcnt_lo(~0u, zz));
        int bx = blockIdx.x, G = gridDim.x; asm volatile("" : "+s"(bx), "+s"(G));
        CArgs a = (CArgs)__builtin_amdgcn_kernarg_segment_ptr(); asm volatile("" : "+s"(a));
        const int lane = tid & 63, wave = __builtin_amdgcn_readfirstlane(tid >> 6);
        const int gw = bx * 8 + wave, NGW = G * 8;
        unsigned char* ws = a->ws;
        bf16_t* XN = (bf16_t*)(ws + WS_XN);
        if (ph == 0) phase0(a, lds, tid, lane, wave, G, bx);
        else {
            const int l = (ph - 1) / 11, sp = (ph - 1) % 11;
            const float* MODl = (const float*)(ws + WS_MOD) + (size_t)l * NB * NMOD;
            unsigned char* wl = ws + WS_W + (size_t)l * WPL;
            const unsigned char* ob = (const unsigned char*)a->out;
            const XBuf X0{(const unsigned char*)a->in[0], (const unsigned char*)a->in[1] - (size_t)TP * 8192, TP, 1};
            const XBuf XA{ob, ob, 0, 0}, XB{ob + (size_t)T * 4096, ob + (size_t)T * 4096, 0, 0};
            const XBuf XC{ws + 956 * MiB, ws + WS_MT - (size_t)17408 * 4096, 17408, 0}, XY{ob, ob, 0, 1};
            const XBuf xin1 = l == 0 ? X0 : XB;
            const XBuf xmid = l == 0 ? XA : XC;
            const XBuf xend = l == 0 ? XB : XY;
            if (sp == 0) { ssm_build(a, l, lds, tid, G, bx); rownorm_phase(xin1, MODl, MODl + 2048, XN, lane, gw, NGW); }
            else if (sp == 1) { pg8::Gemm g{XN, (const bf16_t*)(wl + W_IN), D, D, D}; pg8::StaticOrder S; S.init(T, NIN, D, G, bx);
                pg8::EpiIn E{(bf16_t*)(ws + WS_U2), (bf16_t*)(ws + WS_PROJ)}; pg8::gemm_phase(lds, tid, g, S, E); }
            else if (sp == 2) { pg8::Gemm g{(const bf16_t*)(ws + WS_U2), (const bf16_t*)(ws + WS_EM), U2_LD, 1024, 1024}; pg8::S1Order S{G, bx};
                pg8::EpiS1 E{(float*)(ws + WS_E)}; pg8::gemm_phase(lds, tid, g, S, E);
                attn_phase(a, l, lds, tid, lane, wave, G, bx);
                conv_phase(a, l, lane, gw, NGW); }
            else if (sp == 3) carry_phase(a, l, lds, tid, lane, wave, G, bx);
            else if (sp == 4) { pg8::Gemm g{(const bf16_t*)(ws + WS_U2), (const bf16_t*)(ws + WS_MT), U2_LD, U2_LD, U2_LD}; pg8::EpiS2 E{(bf16_t*)(ws + WS_YG)};
                if (G == 256) { pg8::S2XcdOrder S{G, bx}; pg8::gemm_phase(lds, tid, g, S, E);
                    if (l == 0 && bx >= 128) transpose_weights(a, lds, TR_ITEMS / 2, TR_ITEMS / 2 + 640, lane, wave, bx - 128, 128); }
                else { pg8::S2Order S{G, bx}; pg8::gemm_phase(lds, tid, g, S, E); } }
            else if (sp == 5) { pg8::Gemm g{(const bf16_t*)(ws + WS_YG), (const bf16_t*)(wl + W_GLU), 512, 512, 512};
                if (G >= T / 256) {
                    LAS float* rss = (LAS float*)(lds + 131072);
                    if (tid < 256) rss[tid] = 0.f;
                    __syncthreads();
                    pg8::GluOrder S{G, bx}; pg8::EpiGlu2 E{(const bf16_t*)(ws + WS_YG), XN, rss}; pg8::gemm_phase(lds, tid, g, S, E);
                    __syncthreads();
                    if (G == 256 && l == 0 && bx >= T / 256) transpose_weights(a, lds, TR_ITEMS / 2 + 640, TR_ITEMS, lane, wave, bx - T / 256, G - T / 256);
                    if (bx < T / 256) { const int wr = wave >> 2, wc = wave & 3, fr = lane & 15, fq = lane >> 4;
#pragma unroll 1
                        for (int pn = 0; pn < 2; ++pn)
#pragma unroll 1
                            for (int bj = 0; bj < 2; ++bj) { const int col = pn * 256 + wc * 32 + 8 * fq + bj * 128;
                                const f32x4 g0 = *(const f32x4*)(a->in[26] + l * D + col), g1 = *(const f32x4*)(a->in[26] + l * D + col + 4);
#pragma unroll
                                for (int am = 0; am < 8; ++am) { const int rl = wr * 64 + fr + (am >> 2) * 128 + (am & 3) * 16; bf16_t* yp = XN + ((size_t)bx * 256 + rl) * D + col;
                                    const float rs = rsqrtf(rss[rl] * (1.0f / 512.0f) + EPS); float y[8]; unpack8(*(const u32x4*)yp, y);
                                    u32x4 w; w.x = pk2(y[0] * rs * g0[0], y[1] * rs * g0[1]); w.y = pk2(y[2] * rs * g0[2], y[3] * rs * g0[3]); w.z = pk2(y[4] * rs * g1[0], y[5] * rs * g1[1]); w.w = pk2(y[6] * rs * g1[2], y[7] * rs * g1[3]);
                                    *(u32x4*)yp = w; } } }
                } else { pg8::StaticOrder S; S.init(T, 512, 512, G, bx);
                    pg8::EpiGlu E{(const bf16_t*)(ws + WS_YG), (float*)(ws + WS_YT)}; pg8::gemm_phase(lds, tid, g, S, E); } }
            else if (sp == 6) { if (G < T / 256) ssmnorm_phase(a, l, lane, gw, NGW); }
            else if (sp == 7 || sp == 10) { const bool o = sp == 7;
                pg8::Gemm g{o ? XN : (const bf16_t*)(ws + WS_HID), (const bf16_t*)(wl + (o ? W_OUT : W_FF2)), o ? D : DFF, o ? D : DFF, o ? D : DFF};
                pg8::StaticOrder S; S.init(T, D, o ? D : DFF, G, bx, true);
                float* PART = (float*)(ws + (o ? WS_HID : WS_XN));
                pg8::EpiRes E{o ? xin1 : xmid, o ? xmid : xend, MODl + (o ? 4096 : 10240), (o ? D : DFF) / 64, PART}; pg8::gemm_phase(lds, tid, g, S, E);
                if (S.split > 1) { xcd_barrier(xbar, tid); reduce_tail(S, PART, MODl + (o ? 4096 : 10240), o ? xin1 : xmid, o ? xmid : xend, lane, wave, G, bx); } }
            else if (sp == 8) rownorm_phase(xmid, MODl + 6144, MODl + 8192, XN, lane, gw, NGW);
            else if (sp == 9) { pg8::Gemm g{XN, (const bf16_t*)(wl + W_FF1), D, D, D}; pg8::EpiFF1 E{(bf16_t*)(ws + WS_HID)};
                if (G == 256) { pg8::FF1Order S{G, bx}; pg8::gemm_phase(lds, tid, g, S, E); }
                else { pg8::StaticOrder S; S.init(T, DFF, D, G, bx); pg8::gemm_phase(lds, tid, g, S, E); } }
        }
        if (ph + 1 < ph_hi && !(ph > 0 && (ph - 1) % 11 == 6 && G >= T / 256)) { if (ph < 0) grid.sync(); else xcd_barrier(xbar, tid); }
#if defined(REP_SYNC)
        xcd_barrier(xbar, tid);
#endif
#if defined(REP_MASK)
        { const int spx = ph == 0 ? 11 : (ph - 1) % 11;
          if (((REP_MASK >> spx) & 1) && !rep) { rep = 1; --ph; } else rep = 0; }
#endif
    }
}

extern "C" void kernel_launch(void* const* d_in, const int* in_sizes, int n_in, void* d_out, int out_size, void* d_ws, size_t ws_size, hipStream_t stream) {
    static int grid = 0;
    if (grid == 0) {
        if (n_in != 30 || (size_t)out_size != O_END || ws_size < WS_END) { fprintf(stderr, "kernel_launch: unexpected shapes: n_in %d out %d (want %zu) ws %zu (want %zu)\n", n_in, out_size, (size_t)O_END, ws_size, (size_t)WS_END); grid = -1; return; }
        int dev = 0, cus = 0, per_cu = 0;
        hipGetDevice(&dev); hipDeviceGetAttribute(&cus, hipDeviceAttributeMultiprocessorCount, dev);
        if (hipFuncSetAttribute((const void*)mega, hipFuncAttributeMaxDynamicSharedMemorySize, LDS_BYTES) != hipSuccess) { fprintf(stderr, "kernel_launch: hipFuncSetAttribute failed\n"); grid = -1; return; }
        if (hipOccupancyMaxActiveBlocksPerMultiprocessor(&per_cu, (const void*)mega, 512, LDS_BYTES) != hipSuccess || per_cu < 1) { fprintf(stderr, "kernel_launch: occupancy query says %d\n", per_cu); per_cu = 1; }
        (void)hipGetLastError();
        grid = cus * per_cu;
    }
    if (grid < 0) return;
    if (hipMemsetAsync(d_ws, 0, 16384, stream) != hipSuccess) { fprintf(stderr, "kernel_launch: memset of the barrier words failed\n"); return; }
    Args a{};
    for (int i = 0; i < 30; ++i) a.in[i] = (const float*)d_in[i];
    a.out = (float*)d_out; a.ws = (unsigned char*)d_ws; a.ph_lo = 0; a.ph_hi = NPH;
    void* args[] = {&a};
    const hipError_t e = hipLaunchCooperativeKernel((const void*)mega, dim3(grid), dim3(512), args, LDS_BYTES, stream);
    if (e != hipSuccess) fprintf(stderr, "kernel_launch: cooperative launch failed: %s (grid %d)\n", hipGetErrorString(e), grid);
}
```

```cpp
#include <hip/hip_runtime.h>
#include <hip/hip_cooperative_groups.h>
#include <cstdio>
namespace cg = cooperative_groups;

#define LAS __attribute__((address_space(3)))
typedef unsigned short bf16_t;
typedef short bf16x8 __attribute__((ext_vector_type(8)));
typedef float f32x4 __attribute__((ext_vector_type(4)));
typedef float f32x2 __attribute__((ext_vector_type(2)));
typedef float f32x16 __attribute__((ext_vector_type(16)));
typedef unsigned u32x4 __attribute__((ext_vector_type(4)));
typedef unsigned u32x2 __attribute__((ext_vector_type(2)));

constexpr int D = 2048, TP = 32768, TS = 2048, T = TP + TS, SEQ = 16384, NIN = 3328, NPJ = 2816, DFF = 8192, NB = 34, NMOD = 12288;
constexpr int PJ_K = 1024, PJ_V = 1152, PJ_GB = 1280, PJ_GC = 1792, PJ_XC = 2304;
constexpr int U2_ROWS = 768, U2_LD = 1280;
constexpr float EPS = 1e-6f;
constexpr size_t O_Y = 0;
constexpr size_t O_NKP = (size_t)T * D;
constexpr size_t O_NVP = O_NKP + 2 * 2 * 128 * 128;
constexpr size_t O_SRP = O_NVP + 2 * 2 * 128 * 128;
constexpr size_t O_SIP = O_SRP + 2 * 2 * 32 * 64;
constexpr size_t O_NCP = O_SIP + 2 * 2 * 32 * 64;
constexpr size_t O_NKS = O_NCP + 2 * 2 * 2 * 512;
constexpr size_t O_NVS = O_NKS + (size_t)2 * 32 * 128 * 128;
constexpr size_t O_SRS = O_NVS + (size_t)2 * 32 * 128 * 128;
constexpr size_t O_SIS = O_SRS + 2 * 32 * 32 * 64;
constexpr size_t O_NCS = O_SIS + 2 * 32 * 32 * 64;
constexpr size_t O_END = O_NCS + 2 * 32 * 2 * 512;
constexpr size_t MiB = 1u << 20;
constexpr size_t WS_BIAS = 1 * MiB;
constexpr size_t WS_A64 = 1 * MiB + 65536;
constexpr size_t WS_MOD = 2 * MiB;
constexpr size_t WS_W = 8 * MiB;
constexpr size_t WPL = 85 * MiB + MiB / 2;
constexpr size_t W_IN = 0, W_OUT = 13 * MiB, W_FF1 = 21 * MiB, W_FF2 = 53 * MiB, W_GLU = 85 * MiB;
constexpr size_t WS_MT = 180 * MiB;
constexpr size_t WS_EM = 260 * MiB;
constexpr size_t WS_XN = 276 * MiB;
constexpr size_t WS_HID = 412 * MiB;
constexpr size_t WS_PROJ = 412 * MiB;
constexpr size_t WS_U2 = 599 * MiB;
constexpr size_t WS_E = 659 * MiB;
constexpr size_t WS_YG = 683 * MiB;
constexpr size_t WS_YT = 717 * MiB;
constexpr size_t WS_END = 1024 * MiB;
constexpr int LDS_BYTES = 147456;
constexpr int NPH = 23;
#ifndef TR_HEAD
#define TR_HEAD 0
#endif
#ifndef AUX_FF2A
#define AUX_FF2A 0
#endif

struct Args { const float* in[30]; float* out; unsigned char* ws; int ph_lo, ph_hi; };
typedef const __attribute__((address_space(4))) Args* CArgs;

__device__ __forceinline__ unsigned f2bf(float f) { unsigned u = __builtin_bit_cast(unsigned, f); return (u + 0x7fffu + ((u >> 16) & 1u)) >> 16; }
typedef __bf16 bf16x2_t __attribute__((ext_vector_type(2)));
__device__ __forceinline__ unsigned pk2(float lo, float hi) { const f32x2 v = {lo, hi}; return __builtin_bit_cast(unsigned, __builtin_convertvector(v, bf16x2_t)); }
__device__ __forceinline__ float bflo(unsigned u) { return __builtin_bit_cast(float, u << 16); }
__device__ __forceinline__ float bfhi(unsigned u) { return __builtin_bit_cast(float, u & 0xffff0000u); }
__device__ __forceinline__ void unpack8(u32x4 w, float* f) { f[0] = bflo(w.x); f[1] = bfhi(w.x); f[2] = bflo(w.y); f[3] = bfhi(w.y); f[4] = bflo(w.z); f[5] = bfhi(w.z); f[6] = bflo(w.w); f[7] = bfhi(w.w); }
__device__ __forceinline__ float wave_sum(float v) {
#pragma unroll
    for (int o = 1; o < 64; o <<= 1) v += __shfl_xor(v, o);
    return v;
}
__device__ __forceinline__ int batch_of(int row) { return row < TP ? (row >> 14) : 2 + ((row - TP) >> 6); }
__device__ __forceinline__ float gelu_tanh(float x) { const float u = 0.7978845608028654f * (x + 0.044715f * x * x * x); return x / (1.0f + __expf(-2.0f * u)); }


struct XBuf { const unsigned char* p0; const unsigned char* p1; int split; int f32; };
__device__ __forceinline__ const unsigned char* xrow(const XBuf& b, int row) { return (row < b.split ? b.p0 : b.p1) + (size_t)row * (b.f32 ? 8192 : 4096); }
__device__ __forceinline__ void xload8(const XBuf& b, int row, int col, float* v) {
    const unsigned char* r = xrow(b, row);
    if (b.f32) { const f32x4 a0 = *(const f32x4*)(r + (size_t)col * 4), a1 = *(const f32x4*)(r + (size_t)col * 4 + 16);
#pragma unroll
        for (int j = 0; j < 4; ++j) { v[j] = a0[j]; v[4 + j] = a1[j]; } }
    else unpack8(*(const u32x4*)(r + (size_t)col * 2), v);
}
__device__ __forceinline__ void xstore8(const XBuf& b, int row, int col, const float* v) {
    unsigned char* r = (unsigned char*)xrow(b, row);
    if (b.f32) { __builtin_nontemporal_store((f32x4){v[0], v[1], v[2], v[3]}, (f32x4*)(r + (size_t)col * 4)); __builtin_nontemporal_store((f32x4){v[4], v[5], v[6], v[7]}, (f32x4*)(r + (size_t)col * 4 + 16)); }
    else { u32x4 w; w.x = pk2(v[0], v[1]); w.y = pk2(v[2], v[3]); w.z = pk2(v[4], v[5]); w.w = pk2(v[6], v[7]); *(u32x4*)(r + (size_t)col * 2) = w; }
}

namespace pg8 {
constexpr int BM = 256, BK = 64, HALF = 128, HTB = HALF * BK * 2, STAGE_BYTES = 8 * HTB, NXCD = 8, WGM = 4;
__device__ __forceinline__ int lds_byte(int r, int c) { const int st = (r >> 4) * 2 + (c >> 5), rr = r & 15, cc = c & 31, ob = rr * 64 + cc * 2; return st * 1024 + (ob ^ (((ob >> 9) & 1) << 5)); }
__device__ __forceinline__ void stage_rc(int b, int& R, int& C) { const int st = b / 1024, sb = b % 1024, swz = sb ^ (((sb >> 9) & 1) << 5); R = (st >> 1) * 16 + swz / 64; C = (st & 1) * 32 + (swz % 64) / 2; }
__device__ __forceinline__ int perm32(int rho) { const int n = rho >> 4, i = rho & 15; return 8 * (i >> 2) + 4 * n + (i & 3); }
struct Unit { int pm, pn, k0, nt, tl; };
struct Gemm { const bf16_t* A; const bf16_t* Bt; int lda, ldb, K; };
struct StaticOrder {
    int nM, nN, nwg, G, c, ntf, nfull, split;
    __device__ __forceinline__ void init(int M, int N, int K, int G_, int c_, bool ksplit = false) { nM = M / BM; nN = N / BM; nwg = nM * nN; G = G_; c = c_; ntf = K / BK; nfull = nwg; split = 1;
        if (ksplit) { const int tail = nwg % G; if (tail > 0 && G % tail == 0 && (ntf % (2 * (G / tail))) == 0) { nfull = nwg - tail; split = G / tail; } } }
    __device__ __forceinline__ bool next(int i, Unit& u) const {
        const int L = i * G + c; int wgid, k0 = 0, nt = ntf, tl = -1;
        if (L < nfull) wgid = L;
        else { tl = L - nfull; if (tl >= (nwg - nfull) * split) return false; wgid = nfull + tl / split; nt = ntf / split; k0 = (tl % split) * nt * BK; }
        { const int q = nwg / NXCD, r = nwg % NXCD, xcd = wgid % NXCD, off = wgid / NXCD; wgid = (xcd < r ? xcd * (q + 1) : r * (q + 1) + (xcd - r) * q) + off; }
        const int nig = WGM * nN, gid = wgid / nig, fm = gid * WGM, gsz = (nM - fm) < WGM ? (nM - fm) : WGM;
        u.pm = fm + ((wgid % nig) % gsz); u.pn = (wgid % nig) / gsz; u.k0 = k0; u.nt = nt; u.tl = tl; return true;
    }
    __device__ __forceinline__ void tile_of(int wgid, int& pm, int& pn) const {
        { const int q = nwg / NXCD, r = nwg % NXCD, xcd = wgid % NXCD, off = wgid / NXCD; wgid = (xcd < r ? xcd * (q + 1) : r * (q + 1) + (xcd - r) * q) + off; }
        const int nig = WGM * nN, gid = wgid / nig, fm = gid * WGM, gsz = (nM - fm) < WGM ? (nM - fm) : WGM;
        pm = fm + ((wgid % nig) % gsz); pn = (wgid % nig) / gsz; }
};
struct FF1Order { int G, c;
    __device__ __forceinline__ bool next(int i, Unit& u) const { if (i >= 17) return false; const int xcd = c & 7, r = c >> 3; u.pm = 8 * i + (r & 7); u.pn = 4 * xcd + (r >> 3); u.k0 = 0; u.nt = 32; u.tl = -1; return true; } };
struct GluOrder { int G, c;
    __device__ __forceinline__ bool next(int i, Unit& u) const { const int pm = c + (i >> 1) * G; if (i > 1 || pm >= T / 256) return false; u.pm = pm; u.pn = i & 1; u.k0 = 0; u.nt = 8; u.tl = -1; return true; } };
struct S1Order { int G, c;
    __device__ __forceinline__ bool next(int i, Unit& u) const { const int L = i * G + c; if (L >= 96) return false; u.pm = L; u.pn = L / 3; u.k0 = 0; u.nt = 16; u.tl = -1; return true; } };
struct S2XcdOrder { int G, c;
    __device__ __forceinline__ bool next(int i, Unit& u) const { const int x = c & 7, u48 = (c >> 3) + 32 * i; if (i > 1 || u48 >= 48) return false;
        const int g = 4 * x + u48 / 12, r = u48 % 12; u.pm = g * 3 + (r >> 2); u.pn = g * 4 + (r & 3); u.k0 = 0; u.nt = 20; u.tl = -1; return true; } };
struct S2Order { int G, c;
    __device__ __forceinline__ bool next(int i, Unit& u) const { const int L = i * G + c; if (L >= 384) return false; const int g = L / 12, r = L % 12; u.pm = g * 3 + (r >> 2); u.pn = g * 4 + (r & 3); u.k0 = 0; u.nt = 20; u.tl = -1; return true; } };

template <int AUXA = 0, class Epi, class Sched>
__device__ __forceinline__ void gemm_phase(LAS unsigned char* lds, const int tid, const Gemm g, const Sched& S, const Epi& E) {
    const int wid = __builtin_amdgcn_readfirstlane(tid >> 6), lane = tid & 63, wr = wid >> 2, wc = wid & 3, fr = lane & 15, fq = lane >> 4;
    unsigned voffA[2], voffB[2];
#pragma unroll
    for (int i = 0; i < 2; ++i) { int R, C; stage_rc(tid * 16 + i * 8192, R, C); const int Rb = Epi::PERM ? ((R & ~31) + perm32(R & 31)) : R;
        voffA[i] = (unsigned)(R * g.lda + C) * 2u; voffB[i] = (unsigned)(Rb * g.ldb + C) * 2u; }
    const size_t kstep = (size_t)(BK * 2);
    const size_t hstepA = (size_t)HALF * g.lda * 2, hstepB = (size_t)HALF * g.ldb * 2;
    const size_t tstepA = 2 * hstepA, tstepB = 2 * hstepB;
    const unsigned ldsw = (unsigned)wid * 1024u;
    const int aoff = lds_byte(wr * 64 + fr, fq * 8), boff = lds_byte(wc * 32 + fr, fq * 8);
#define PG8_SA(b, h) (((b) * 2 + (h)) * HTB)
#define PG8_SB(b, h) ((4 + (b) * 2 + (h)) * HTB)
#define PG8_STAGE(bufoff, gbase, voff) do { _Pragma("unroll") for (int _i = 0; _i < 2; ++_i) \
        __builtin_amdgcn_global_load_lds((const unsigned*)((const char*)(gbase) + (voff)[_i]), (LAS unsigned*)(lds + (bufoff) + ldsw + _i * 8192), 16, 0, 0); } while (0)
#define PG8_STAGEA(bufoff, gbase, voff) do { _Pragma("unroll") for (int _i = 0; _i < 2; ++_i) \
        __builtin_amdgcn_global_load_lds((const unsigned*)((const char*)(gbase) + (voff)[_i]), (LAS unsigned*)(lds + (bufoff) + ldsw + _i * 8192), 16, 0, AUXA); } while (0)
#define PG8_LDA(dst, b, h) do { _Pragma("unroll") for (int m = 0; m < 4; ++m) _Pragma("unroll") for (int k = 0; k < 2; ++k) dst[m][k] = *(const LAS bf16x8*)(lds + PG8_SA(b, h) + aoff + m * 2048 + k * 1024); } while (0)
#define PG8_LDB(dst, b, h) do { _Pragma("unroll") for (int n = 0; n < 2; ++n) _Pragma("unroll") for (int k = 0; k < 2; ++k) dst[n][k] = *(const LAS bf16x8*)(lds + PG8_SB(b, h) + boff + n * 2048 + k * 1024); } while (0)
#define PG8_MMA(ai, bj, At, Bt) do { __builtin_amdgcn_s_setprio(1); _Pragma("unroll") for (int m = 0; m < 4; ++m) _Pragma("unroll") for (int n = 0; n < 2; ++n) _Pragma("unroll") for (int k = 0; k < 2; ++k) \
        acc[ai][bj][m][n] = __builtin_amdgcn_mfma_f32_16x16x32_bf16(Bt[n][k], At[m][k], acc[ai][bj][m][n], 0, 0, 0); __builtin_amdgcn_s_setprio(0); } while (0)
#define PG8_WAIT_V(n) asm volatile("s_waitcnt vmcnt(" #n ")" ::: "memory")
#define PG8_WAIT_L(n) asm volatile("s_waitcnt lgkmcnt(" #n ")" ::: "memory")
#define PG8_BAR __builtin_amdgcn_s_barrier()
#define PG8_SCHED __builtin_amdgcn_sched_barrier(0)
    Unit cur, nxt; int ui = 0;
    if (!S.next(0, cur)) return;
    f32x4 acc[2][2][4][2];
#pragma unroll
    for (int a = 0; a < 2; ++a)
#pragma unroll
        for (int b = 0; b < 2; ++b)
#pragma unroll
            for (int m = 0; m < 4; ++m)
#pragma unroll
                for (int n = 0; n < 2; ++n) acc[a][b][m][n] = (f32x4){0.f, 0.f, 0.f, 0.f};
    bf16x8 At[4][2], B0[2][2], B1[2][2];
    const char* cA = (const char*)g.A + (size_t)cur.pm * tstepA + (size_t)cur.k0 * 2; const char* cB = (const char*)g.Bt + (size_t)cur.pn * tstepB + (size_t)cur.k0 * 2;
    PG8_STAGE(PG8_SB(0, 0), cB, voffB); PG8_STAGE(PG8_SB(0, 1), cB + hstepB, voffB); PG8_STAGEA(PG8_SA(0, 0), cA, voffA); PG8_STAGEA(PG8_SA(0, 1), cA + hstepA, voffA);
    if (wr == 1) PG8_BAR;
    PG8_WAIT_V(2); PG8_BAR;
    PG8_STAGE(PG8_SB(1, 0), cB + kstep, voffB); PG8_STAGEA(PG8_SA(1, 0), cA + kstep, voffA); PG8_STAGE(PG8_SB(1, 1), cB + hstepB + kstep, voffB);
    PG8_WAIT_V(6); PG8_BAR;
    for (;;) {
        const bool has_next = S.next(ui + 1, nxt);
        const char* nA = has_next ? (const char*)g.A + (size_t)nxt.pm * tstepA + (size_t)nxt.k0 * 2 : cA; const char* nB = has_next ? (const char*)g.Bt + (size_t)nxt.pn * tstepB + (size_t)nxt.k0 * 2 : cB;
        const int nt = cur.nt;
        for (int t = 0; t < nt; t += 2) {
            const bool last = (t == nt - 2);
            const char* a1 = cA + (size_t)(t + 1) * kstep;
            const char* a2 = last ? nA : cA + (size_t)(t + 2) * kstep; const char* b2 = last ? nB : cB + (size_t)(t + 2) * kstep;
            const char* a3 = a2 + kstep; const char* b3 = b2 + kstep;
            PG8_LDB(B0, 0, 0); PG8_LDB(B1, 0, 1); PG8_SCHED; PG8_LDA(At, 0, 0); PG8_STAGEA(PG8_SA(1, 1), a1 + hstepA, voffA);
            PG8_WAIT_V(8); PG8_WAIT_L(0); PG8_BAR; PG8_MMA(0, 0, At, B0); PG8_MMA(0, 1, At, B1); PG8_BAR; PG8_SCHED;
            PG8_LDA(At, 0, 1); PG8_STAGE(PG8_SB(0, 0), b2, voffB); PG8_STAGE(PG8_SB(0, 1), b2 + hstepB, voffB); PG8_STAGEA(PG8_SA(0, 0), a2, voffA);
            PG8_WAIT_V(8); PG8_WAIT_L(0); PG8_BAR; PG8_MMA(1, 0, At, B0); PG8_MMA(1, 1, At, B1); PG8_BAR; PG8_SCHED;
            PG8_LDB(B0, 1, 0); PG8_LDB(B1, 1, 1); PG8_SCHED; PG8_LDA(At, 1, 0); PG8_STAGEA(PG8_SA(0, 1), a2 + hstepA, voffA);
            PG8_WAIT_V(8); PG8_WAIT_L(0); PG8_BAR; PG8_MMA(0, 0, At, B0); PG8_MMA(0, 1, At, B1); PG8_BAR; PG8_SCHED;
            PG8_LDA(At, 1, 1); PG8_STAGE(PG8_SB(1, 0), b3, voffB); PG8_STAGE(PG8_SB(1, 1), b3 + hstepB, voffB); PG8_STAGEA(PG8_SA(1, 0), a3, voffA);
            PG8_WAIT_V(8); PG8_WAIT_L(0); PG8_BAR; PG8_MMA(1, 0, At, B0); PG8_MMA(1, 1, At, B1); PG8_BAR; PG8_SCHED;
        }
        if (wr == 0) PG8_BAR;
        E(acc, cur, wr, wc, fr, fq);
        if (!has_next) break;
#pragma unroll
        for (int a = 0; a < 2; ++a)
#pragma unroll
            for (int b = 0; b < 2; ++b)
#pragma unroll
                for (int m = 0; m < 4; ++m)
#pragma unroll
                    for (int n = 0; n < 2; ++n) acc[a][b][m][n] = (f32x4){0.f, 0.f, 0.f, 0.f};
        cur = nxt; cA = nA; cB = nB; ++ui;
        if (wr == 1) PG8_BAR;
    }
    PG8_WAIT_V(0);
    PG8_BAR;
#undef PG8_SA
#undef PG8_SB
#undef PG8_STAGE
#undef PG8_STAGEA
#undef PG8_LDA
#undef PG8_LDB
#undef PG8_MMA
#undef PG8_WAIT_V
#undef PG8_WAIT_L
#undef PG8_BAR
#undef PG8_SCHED
}

__device__ __forceinline__ u32x4 pack8(f32x4 v0, f32x4 v1) { u32x4 w; w.x = pk2(v0[0], v0[1]); w.y = pk2(v0[2], v0[3]); w.z = pk2(v1[0], v1[1]); w.w = pk2(v1[2], v1[3]); return w; }

struct EpiIn {
    static constexpr bool PERM = true;
    bf16_t* U2; bf16_t* PROJ;
    __device__ __forceinline__ void operator()(const f32x4 (&acc)[2][2][4][2], const Unit& u, int wr, int wc, int fr, int fq) const {
        const int row0 = u.pm * BM + wr * 64 + fr, colb = u.pn * BM + wc * 32 + 8 * fq;
#pragma unroll
        for (int ai = 0; ai < 2; ++ai)
#pragma unroll
            for (int m = 0; m < 4; ++m) { const int row = row0 + ai * HALF + m * 16;
#pragma unroll
                for (int bj = 0; bj < 2; ++bj) { const int col = colb + bj * HALF; const u32x4 w = pack8(acc[ai][bj][m][0], acc[ai][bj][m][1]);
                    bf16_t* dst;
                    if (u.pn < 2) dst = U2 + ((size_t)((col >> 4) * U2_ROWS + (row >> 6)) * U2_LD + (row & 63) * 16 + (col & 15));
                    else dst = PROJ + (size_t)row * NPJ + (col - 512);
                    *(u32x4*)dst = w; } }
    }
};
struct EpiRes {
    static constexpr bool PERM = true;
    XBuf xin, xout; const float* gate; int ntf; float* part;
    __device__ __forceinline__ void operator()(const f32x4 (&acc)[2][2][4][2], const Unit& u, int wr, int wc, int fr, int fq) const {
        const int row0 = u.pm * BM + wr * 64 + fr, col0 = u.pn * BM + wc * 32 + 8 * fq;
        if (u.nt != ntf) {
#pragma unroll
            for (int ai = 0; ai < 2; ++ai)
#pragma unroll
                for (int m = 0; m < 4; ++m)
#pragma unroll
                    for (int bj = 0; bj < 2; ++bj) { float* pp = part + ((size_t)u.tl * 256 + (wr * 64 + fr + ai * HALF + m * 16)) * 256 + wc * 32 + 8 * fq + bj * HALF;
                        *(f32x4*)pp = acc[ai][bj][m][0]; *(f32x4*)(pp + 4) = acc[ai][bj][m][1]; }
            return; }
#pragma unroll
        for (int ai = 0; ai < 2; ++ai) {
            const int bi = batch_of(row0 + ai * HALF);
            f32x4 gv[2][2];
#pragma unroll
            for (int bj = 0; bj < 2; ++bj)
#pragma unroll
                for (int n = 0; n < 2; ++n) gv[bj][n] = *(const f32x4*)(gate + (size_t)bi * NMOD + col0 + bj * HALF + n * 4);
#pragma unroll
            for (int m = 0; m < 4; ++m) { const int row = row0 + ai * HALF + m * 16;
                float xv[2][8];
#pragma unroll
                for (int bj = 0; bj < 2; ++bj) xload8(xin, row, col0 + bj * HALF, xv[bj]);
#pragma unroll
                for (int bj = 0; bj < 2; ++bj) { float o[8];
#pragma unroll
                    for (int j = 0; j < 4; ++j) { o[j] = xv[bj][j] + gv[bj][0][j] * acc[ai][bj][m][0][j]; o[4 + j] = xv[bj][4 + j] + gv[bj][1][j] * acc[ai][bj][m][1][j]; }
                    xstore8(xout, row, col0 + bj * HALF, o); }
                if (m & 1) asm volatile("" ::: "memory"); }
        }
    }
};
struct EpiFF1 {
    static constexpr bool PERM = true;
    bf16_t* O;
    __device__ __forceinline__ void operator()(const f32x4 (&acc)[2][2][4][2], const Unit& u, int wr, int wc, int fr, int fq) const {
        const int row0 = u.pm * BM + wr * 64 + fr, col0 = u.pn * BM + wc * 32 + 8 * fq;
#pragma unroll
        for (int ai = 0; ai < 2; ++ai)
#pragma unroll
            for (int m = 0; m < 4; ++m) { bf16_t* rowp = O + (size_t)(row0 + ai * HALF + m * 16) * DFF + col0;
#pragma unroll
                for (int bj = 0; bj < 2; ++bj) { f32x4 v0 = acc[ai][bj][m][0], v1 = acc[ai][bj][m][1];
#pragma unroll
                    for (int j = 0; j < 4; ++j) { const float a0 = fmaxf(v0[j], 0.f), a1 = fmaxf(v1[j], 0.f); v0[j] = a0 * a0; v1[j] = a1 * a1; }
                    __builtin_nontemporal_store(pack8(v0, v1), (u32x4*)(rowp + bj * HALF)); } }
    }
};
struct EpiS1 {
    static constexpr bool PERM = false;
    float* Eo;
    __device__ __forceinline__ void operator()(const f32x4 (&acc)[2][2][4][2], const Unit& u, int wr, int wc, int fr, int fq) const {
        const int row0 = u.pm * BM + wr * 64 + fr, col0 = wc * 32 + 4 * fq;
#pragma unroll
        for (int ai = 0; ai < 2; ++ai)
#pragma unroll
            for (int m = 0; m < 4; ++m) { float* rowp = Eo + (size_t)(row0 + ai * HALF + m * 16) * 256 + col0;
#pragma unroll
                for (int bj = 0; bj < 2; ++bj)
#pragma unroll
                    for (int n = 0; n < 2; ++n) *(f32x4*)(rowp + bj * HALF + n * 16) = acc[ai][bj][m][n]; }
    }
};
struct EpiS2 {
    static constexpr bool PERM = true;
    bf16_t* YG;
    __device__ __forceinline__ void operator()(const f32x4 (&acc)[2][2][4][2], const Unit& u, int wr, int wc, int fr, int fq) const {
        const int g = u.pm / 3, i3 = u.pm - 3 * g, j4 = u.pn & 3;
        const int cr0 = i3 * BM + wr * 64 + fr, cb = j4 * BM + wc * 32 + 8 * fq;
#pragma unroll
        for (int ai = 0; ai < 2; ++ai)
#pragma unroll
            for (int m = 0; m < 4; ++m) { const int cr = cr0 + ai * HALF + m * 16;
                if (cr < 544) {
#pragma unroll
                    for (int bj = 0; bj < 2; ++bj) { const int c = cb + bj * HALF; f32x4 v0 = acc[ai][bj][m][0], v1 = acc[ai][bj][m][1];
#pragma unroll
                        for (int j = 0; j < 4; ++j) { v0[j] = gelu_tanh(v0[j]); v1[j] = gelu_tanh(v1[j]); }
                        *(u32x4*)(YG + (size_t)(cr * 64 + (c >> 4)) * 512 + g * 16 + (c & 15)) = pack8(v0, v1); } } }
    }
};
struct EpiGlu2 {
    static constexpr bool PERM = true;
    const bf16_t* YG; bf16_t* YC; LAS float* rss;
    __device__ __forceinline__ void operator()(const f32x4 (&acc)[2][2][4][2], const Unit& u, int wr, int wc, int fr, int fq) const {
        const int col0 = u.pn * BM + wc * 32 + 8 * fq;
#pragma unroll
        for (int ai = 0; ai < 2; ++ai)
#pragma unroll
            for (int m = 0; m < 4; ++m) { const int rl = wr * 64 + fr + ai * HALF + m * 16; const size_t row = (size_t)u.pm * BM + rl; float part = 0.f;
#pragma unroll
                for (int bj = 0; bj < 2; ++bj) { const int col = col0 + bj * HALF; const u32x4 yw = *(const u32x4*)(YG + row * 512 + col); float y[8], o[8]; unpack8(yw, y);
                    const f32x4 v0 = acc[ai][bj][m][0], v1 = acc[ai][bj][m][1];
#pragma unroll
                    for (int j = 0; j < 4; ++j) { o[j] = y[j] / (1.0f + __expf(-v0[j])); o[4 + j] = y[4 + j] / (1.0f + __expf(-v1[j])); }
#pragma unroll
                    for (int j = 0; j < 8; ++j) part += o[j] * o[j];
                    u32x4 w; w.x = pk2(o[0], o[1]); w.y = pk2(o[2], o[3]); w.z = pk2(o[4], o[5]); w.w = pk2(o[6], o[7]);
                    *(u32x4*)(YC + row * D + col) = w; }
                part += __shfl_xor(part, 16); part += __shfl_xor(part, 32);
                if (fq == 0) (void)__hip_atomic_fetch_add(rss + rl, part, __ATOMIC_RELAXED, __HIP_MEMORY_SCOPE_WORKGROUP); }
    }
};
struct EpiGlu {
    static constexpr bool PERM = true;
    const bf16_t* YG; float* YT;
    __device__ __forceinline__ void operator()(const f32x4 (&acc)[2][2][4][2], const Unit& u, int wr, int wc, int fr, int fq) const {
        const int row0 = u.pm * BM + wr * 64 + fr, col0 = u.pn * BM + wc * 32 + 8 * fq;
#pragma unroll
        for (int ai = 0; ai < 2; ++ai)
#pragma unroll
            for (int m = 0; m < 4; ++m) { const size_t ro = (size_t)(row0 + ai * HALF + m * 16) * 512 + col0;
#pragma unroll
                for (int bj = 0; bj < 2; ++bj) { const u32x4 yw = *(const u32x4*)(YG + ro + bj * HALF); float y[8]; unpack8(yw, y);
                    const f32x4 v0 = acc[ai][bj][m][0], v1 = acc[ai][bj][m][1]; f32x4 o0, o1;
#pragma unroll
                    for (int j = 0; j < 4; ++j) { o0[j] = y[j] / (1.0f + __expf(-v0[j])); o1[j] = y[4 + j] / (1.0f + __expf(-v1[j])); }
                    *(f32x4*)(YT + ro + bj * HALF) = o0; *(f32x4*)(YT + ro + bj * HALF + 4) = o1; } }
    }
};
}

__device__ __forceinline__ double SC(double c) { asm volatile("" : "+s"(c)); return c; }
__device__ __forceinline__ double dexp_(double x) {
    const double n = __builtin_rint(x * SC(1.4426950408889634));
    const double r = (x - n * SC(0.693147180369123816490)) - n * SC(1.90821492927058770002e-10);
    double p = SC(1.0 / 6227020800.0);
    p = p * r + SC(1.0 / 479001600.0); p = p * r + SC(1.0 / 39916800.0); p = p * r + SC(1.0 / 3628800.0); p = p * r + SC(1.0 / 362880.0); p = p * r + SC(1.0 / 40320.0);
    p = p * r + SC(1.0 / 5040.0); p = p * r + SC(1.0 / 720.0); p = p * r + SC(1.0 / 120.0); p = p * r + SC(1.0 / 24.0); p = p * r + SC(1.0 / 6.0); p = p * r + SC(0.5); p = p * r + SC(1.0); p = p * r + SC(1.0);
    const long long e = (long long)(1023 + (int)n) << 52;
    return p * __builtin_bit_cast(double, e);
}
__device__ __forceinline__ void dsincos_(double x, double& s, double& c) {
    const double kf = __builtin_rint(x * SC(0.63661977236758134308));
    const double r = (x - kf * SC(1.57079632673412561417)) - kf * SC(6.07710050650619224932e-11);
    const double z = r * r;
    double ps = SC(1.0 / 355687428096000.0);
    ps = ps * z - SC(1.0 / 1307674368000.0); ps = ps * z + SC(1.0 / 6227020800.0); ps = ps * z - SC(1.0 / 39916800.0); ps = ps * z + SC(1.0 / 362880.0); ps = ps * z - SC(1.0 / 5040.0); ps = ps * z + SC(1.0 / 120.0); ps = ps * z - SC(1.0 / 6.0);
    const double sr = r + r * z * ps;
    double pc = -SC(1.0 / 6402373705728000.0);
    pc = pc * z + SC(1.0 / 20922789888000.0); pc = pc * z - SC(1.0 / 87178291200.0); pc = pc * z + SC(1.0 / 479001600.0); pc = pc * z - SC(1.0 / 3628800.0); pc = pc * z + SC(1.0 / 40320.0); pc = pc * z - SC(1.0 / 720.0); pc = pc * z + SC(1.0 / 24.0); pc = pc * z - SC(0.5);
    const double cr = SC(1.0) + z * pc;
    const int k = ((int)kf) & 3;
    s = (k == 0) ? sr : (k == 1) ? cr : (k == 2) ? -sr : -cr;
    c = (k == 0) ? cr : (k == 1) ? -sr : (k == 2) ? -cr : sr;
}

__device__ __forceinline__ void transpose_tile(const float* W, int K, int N, bf16_t* WT, LAS float* T_, int item, int lane, int wave) {
    const int nnb = N / 256, kb = item / nnb, nb = item % nnb, k0 = 128 * kb, n0 = 256 * nb;
    __syncthreads();
#pragma unroll 1
    for (int hb = 0; hb < 16; hb += 8) { float tv[8][4];
#pragma unroll
        for (int i = 0; i < 8; ++i)
#pragma unroll
            for (int j = 0; j < 4; ++j) tv[i][j] = __builtin_nontemporal_load(W + (size_t)(k0 + wave * 16 + hb + i) * N + n0 + lane + 64 * j);
#pragma unroll
        for (int i = 0; i < 8; ++i)
#pragma unroll
            for (int j = 0; j < 4; ++j) T_[(wave * 16 + hb + i) * 257 + lane + 64 * j] = tv[i][j]; }
    __syncthreads();
    const int c = lane & 15;
#pragma unroll
    for (int j = 0; j < 8; ++j) { const int n = (lane >> 4) + 4 * wave + 32 * j; const LAS float* s = T_ + (8 * c) * 257 + n;
        u32x4 o; o.x = pk2(s[0 * 257], s[1 * 257]); o.y = pk2(s[2 * 257], s[3 * 257]); o.z = pk2(s[4 * 257], s[5 * 257]); o.w = pk2(s[6 * 257], s[7 * 257]);
        *(u32x4*)(WT + (size_t)(n0 + n) * K + k0 + 8 * c) = o; }
}
__device__ __forceinline__ void transpose_weights(CArgs a, LAS unsigned char* lds, int lo, int hi, int lane, int wave, int wi, int nw) {
    LAS float* T_ = (LAS float*)lds;
    constexpr int I_IN = 16 * 13, I_OUT = 16 * 8, I_F1 = 16 * 32, I_F2 = 64 * 8, I_GL = 4 * 2, I_L = I_IN + I_OUT + I_F1 + I_F2 + I_GL;
    for (int it = lo + wi; it < hi; it += nw) {
        const int l = it / I_L; int r = it - l * I_L; unsigned char* wl = a->ws + WS_W + (size_t)l * WPL;
        if (r < I_IN) { transpose_tile(a->in[12] + (size_t)l * D * NIN, D, NIN, (bf16_t*)(wl + W_IN), T_, r, lane, wave); continue; } r -= I_IN;
        if (r < I_OUT) { transpose_tile(a->in[27] + (size_t)l * D * D, D, D, (bf16_t*)(wl + W_OUT), T_, r, lane, wave); continue; } r -= I_OUT;
        if (r < I_F1) { transpose_tile(a->in[28] + (size_t)l * D * DFF, D, DFF, (bf16_t*)(wl + W_FF1), T_, r, lane, wave); continue; } r -= I_F1;
        if (r < I_F2) { transpose_tile(a->in[29] + (size_t)l * DFF * D, DFF, D, (bf16_t*)(wl + W_FF2), T_, r, lane, wave); continue; } r -= I_F2;
        transpose_tile(a->in[21] + (size_t)l * 512 * 512, 512, 512, (bf16_t*)(wl + W_GLU), T_, r, lane, wave);
    }
    __syncthreads();
}
constexpr int TR_ITEMS = 2 * (16 * 13 + 16 * 8 + 16 * 32 + 64 * 8 + 4 * 2);

__device__ __forceinline__ void phase0(CArgs a, LAS unsigned char* lds, int tid, int lane, int wave, int G, int bx) {
    unsigned char* ws = a->ws;
    for (int it = bx; it < 192; it += G) {
        const int l = it / 96, cb = it % 96;
        LAS float* S = (LAS float*)lds;
        f32x2 acc[NB];
#pragma unroll
        for (int r = 0; r < NB; ++r) acc[r] = (f32x2){0.f, 0.f};
        const float* Wl = a->in[10] + (size_t)l * D * NMOD + cb * 128 + lane * 2;
        for (int half = 0; half < 2; ++half) {
            __syncthreads();
            for (int idx = tid; idx < NB * 1024; idx += 512) { const int r = idx >> 10, k = idx & 1023;
                const float c = r < 2 ? a->in[7][r * D + half * 1024 + k] : a->in[8][(r - 2) * D + half * 1024 + k];
                S[idx] = c / (1.0f + __expf(-c)); }
            __syncthreads();
            const int kb = wave * 128;
            for (int kk = 0; kk < 128; kk += 16) {
                const int k = kb + kk; const float* wp = Wl + (size_t)(half * 1024 + k) * NMOD;
                f32x2 wv[16];
#pragma unroll
                for (int i = 0; i < 16; ++i) wv[i] = __builtin_nontemporal_load((const f32x2*)(wp + (size_t)i * NMOD));
#pragma unroll
                for (int q = 0; q < 4; ++q) {
#pragma unroll
                    for (int r = 0; r < NB; ++r) { const f32x4 s4 = *(const LAS f32x4*)(S + r * 1024 + k + 4 * q);
                        acc[r] += wv[4 * q] * s4[0]; acc[r] += wv[4 * q + 1] * s4[1]; acc[r] += wv[4 * q + 2] * s4[2]; acc[r] += wv[4 * q + 3] * s4[3]; } }
            }
        }
        __syncthreads();
#pragma unroll
        for (int r = 0; r < NB; ++r) *(LAS f32x2*)(S + (wave * NB + r) * 128 + lane * 2) = acc[r];
        __syncthreads();
        float* MOD = (float*)(ws + WS_MOD);
        for (int idx = tid; idx < NB * 128; idx += 512) { const int r = idx >> 7, col = idx & 127; float s = a->in[11][l * NMOD + cb * 128 + col];
#pragma unroll
            for (int w = 0; w < 8; ++w) s += S[(w * NB + r) * 128 + col];
            MOD[(size_t)(l * NB + r) * NMOD + cb * 128 + col] = s; }
        __syncthreads();
    }
    if (bx == G - 1) {
        float* BL = (float*)(ws + WS_BIAS);
        for (int idx = tid; idx < 4096; idx += 512) { const int h = idx >> 8, ri = idx & 255; const int rel = ri - 191; const int n = rel < 0 ? -rel : rel;
            int bk; if (n < 8) bk = n; else { int far = 8 + (int)(logf((float)n * 0.125f) / 2.0794415416798357f * 8.0f); bk = far < 15 ? far : 15; }
            if (rel > 0) bk += 16;
            BL[idx] = a->in[9][bk * 16 + h]; }
    }
    __syncthreads();
    transpose_weights(a, lds, 0, G == 256 ? TR_ITEMS / 2 : TR_ITEMS, lane, wave, bx, G);
}

__device__ __forceinline__ void rownorm_phase(const XBuf xin, const float* mod_shift, const float* mod_scale, bf16_t* XN, int lane, int gw, int NGW) {
    for (int row0 = gw * 2; row0 < T; row0 += NGW * 2) {
        const int bi = batch_of(row0);
        float v[2][4][8]; float ss0 = 0.f, ss1 = 0.f;
#pragma unroll
        for (int j = 0; j < 4; ++j) { xload8(xin, row0, 8 * lane + 512 * j, v[0][j]); xload8(xin, row0 + 1, 8 * lane + 512 * j, v[1][j]); }
#pragma unroll
        for (int j = 0; j < 4; ++j)
#pragma unroll
            for (int k = 0; k < 8; ++k) { ss0 += v[0][j][k] * v[0][j][k]; ss1 += v[1][j][k] * v[1][j][k]; }
        const float rs0 = rsqrtf(wave_sum(ss0) * (1.0f / D) + EPS), rs1 = rsqrtf(wave_sum(ss1) * (1.0f / D) + EPS);
        const float* sh = mod_shift + (size_t)bi * NMOD; const float* sc = mod_scale + (size_t)bi * NMOD;
#pragma unroll
        for (int j = 0; j < 4; ++j) { const int c = 8 * lane + 512 * j;
            const f32x4 s0 = 1.0f + *(const f32x4*)(sc + c), s1 = 1.0f + *(const f32x4*)(sc + c + 4), h0 = *(const f32x4*)(sh + c), h1 = *(const f32x4*)(sh + c + 4);
            u32x4 w0, w1;
            w0.x = pk2(v[0][j][0] * rs0 * s0[0] + h0[0], v[0][j][1] * rs0 * s0[1] + h0[1]); w0.y = pk2(v[0][j][2] * rs0 * s0[2] + h0[2], v[0][j][3] * rs0 * s0[3] + h0[3]);
            w0.z = pk2(v[0][j][4] * rs0 * s1[0] + h1[0], v[0][j][5] * rs0 * s1[1] + h1[1]); w0.w = pk2(v[0][j][6] * rs0 * s1[2] + h1[2], v[0][j][7] * rs0 * s1[3] + h1[3]);
            w1.x = pk2(v[1][j][0] * rs1 * s0[0] + h0[0], v[1][j][1] * rs1 * s0[1] + h0[1]); w1.y = pk2(v[1][j][2] * rs1 * s0[2] + h0[2], v[1][j][3] * rs1 * s0[3] + h0[3]);
            w1.z = pk2(v[1][j][4] * rs1 * s1[0] + h1[0], v[1][j][5] * rs1 * s1[1] + h1[1]); w1.w = pk2(v[1][j][6] * rs1 * s1[2] + h1[2], v[1][j][7] * rs1 * s1[3] + h1[3]);
            *(u32x4*)(XN + (size_t)row0 * D + c) = w0; *(u32x4*)(XN + (size_t)(row0 + 1) * D + c) = w1; }
    }
}

__device__ __forceinline__ void ssm_build(CArgs a, int l, LAS unsigned char* lds, int tid, int G, int bx) {
    LAS float* PR = (LAS float*)lds;
    LAS float* PI = PR + 64 * 65;
    LAS float* WR = PI + 64 * 65;
    LAS float* WI = WR + 1024;
    LAS float* CC = WI + 1024;
    LAS float* KT = CC + 2048;
    bf16_t* MT = (bf16_t*)(a->ws + WS_MT); bf16_t* EM = (bf16_t*)(a->ws + WS_EM); float* A64 = (float*)(a->ws + WS_A64);
    for (int it = bx; it < 256; it += G) {
        const int g = it >> 3, part = it & 7;
        __syncthreads();
        if (tid < 64) { const int p = tid;
            const double dt = dexp_((double)a->in[15][l * 32 + g]);
            const double ar = (double)a->in[13][(l * 32 + g) * 64 + p], ai = (double)a->in[14][(l * 32 + g) * 64 + p];
            const double mag = dexp_(dt * ar); double sn, cs; dsincos_(dt * ai, sn, cs);
            const double abr = mag * cs, abi = mag * sn, den = ar * ar + ai * ai;
            const double fr = ((abr - 1.0) * ar + abi * ai) / den, fi = (abi * ar - (abr - 1.0) * ai) / den;
            double pr = 1.0, pi = 0.0;
            for (int j = 0; j <= 64; ++j) { PR[p * 65 + j] = (float)pr; PI[p * 65 + j] = (float)pi; const double nr = pr * abr - pi * abi, ni = pr * abi + pi * abr; pr = nr; pi = ni; }
            if (part == 0) { A64[(g * 64 + p) * 2] = PR[p * 65 + 64]; A64[(g * 64 + p) * 2 + 1] = PI[p * 65 + 64]; }
            for (int hi = 0; hi < 16; ++hi) { const double br = (double)a->in[16][((size_t)(l * 32 + g) * 64 + p) * 16 + hi], bi = (double)a->in[17][((size_t)(l * 32 + g) * 64 + p) * 16 + hi];
                WR[p * 16 + hi] = (float)(fr * br - fi * bi); WI[p * 16 + hi] = (float)(fr * bi + fi * br); }
        }
        for (int idx = tid; idx < 1024; idx += 512) { const int ho = idx >> 6, p = idx & 63; CC[p * 32 + ho * 2] = a->in[18][(size_t)(l * 32 + g) * 1024 + idx]; CC[p * 32 + ho * 2 + 1] = a->in[19][(size_t)(l * 32 + g) * 1024 + idx]; }
        __syncthreads();
#pragma unroll 1
        for (int r = 0; r < 2; ++r) { const int idx = tid + 512 * r, j = idx >> 4, hi = idx & 15; float acc[16];
#pragma unroll
            for (int ho = 0; ho < 16; ++ho) acc[ho] = 0.f;
#pragma unroll 2
            for (int p = 0; p < 64; ++p) { const float pr = PR[p * 65 + j], pi = PI[p * 65 + j], wr = WR[p * 16 + hi], wi = WI[p * 16 + hi];
                const float tr = pr * wr - pi * wi, ti = pr * wi + pi * wr;
#pragma unroll
                for (int q = 0; q < 8; ++q) { const f32x4 c4 = *(const LAS f32x4*)(CC + p * 32 + q * 4); acc[2 * q] += c4[0] * tr - c4[1] * ti; acc[2 * q + 1] += c4[2] * tr - c4[3] * ti; } }
#pragma unroll
            for (int ho = 0; ho < 16; ++ho) KT[j * 256 + ho * 16 + hi] = acc[ho]; }
        __syncthreads();
        for (int pc = tid; pc < 128 * 160; pc += 512) { const int rl = pc / 160, c8 = pc % 160; const int t = 8 * part + (rl >> 4), ho = rl & 15; const int c0 = c8 * 8; float v[8];
            if (c0 < 1024) { const int s = c0 >> 4, hi0 = c0 & 15;
                if (t >= s) { const f32x4 k0 = *(const LAS f32x4*)(KT + (t - s) * 256 + ho * 16 + hi0), k1 = *(const LAS f32x4*)(KT + (t - s) * 256 + ho * 16 + hi0 + 4);
#pragma unroll
                    for (int k = 0; k < 4; ++k) { v[k] = k0[k]; v[4 + k] = k1[k]; }
                    if (t == s && (ho >> 3) == (hi0 >> 3)) { const float dsk = a->in[20][l * 512 + g * 16 + ho];
#pragma unroll
                        for (int k = 0; k < 8; ++k) v[k] += (hi0 + k == ho) ? dsk : 0.f; }
                } else {
#pragma unroll
                    for (int k = 0; k < 8; ++k) v[k] = 0.f; }
            } else { const int cc = (c0 - 1024) & 127;
#pragma unroll
                for (int k = 0; k < 8; ++k) { const int col = cc + k, ri = col >> 6, p = col & 63; const float pr = PR[p * 65 + t + 1], pi = PI[p * 65 + t + 1], cr = CC[p * 32 + ho * 2], ci = CC[p * 32 + ho * 2 + 1];
                    v[k] = ri == 0 ? (cr * pr - ci * pi) : -(cr * pi + ci * pr); }
            }
            u32x4 w; w.x = pk2(v[0], v[1]); w.y = pk2(v[2], v[3]); w.z = pk2(v[4], v[5]); w.w = pk2(v[6], v[7]);
            *(u32x4*)(MT + ((size_t)(g * 1024 + t * 16 + ho)) * U2_LD + c0) = w; }
        for (int pc = tid; pc < 32 * 128; pc += 512) { const int row = 32 * part + (pc >> 7), c0 = (pc & 127) * 8; float v[8];
            if (row < 128) { const int ri = row >> 6, p = row & 63, s = c0 >> 4, hi0 = c0 & 15; const float pr = PR[p * 65 + 63 - s], pi = PI[p * 65 + 63 - s];
#pragma unroll
                for (int k = 0; k < 8; ++k) { const float wr = WR[p * 16 + hi0 + k], wi = WI[p * 16 + hi0 + k]; v[k] = ri == 0 ? (pr * wr - pi * wi) : (pr * wi + pi * wr); }
            } else {
#pragma unroll
                for (int k = 0; k < 8; ++k) v[k] = 0.f; }
            u32x4 w; w.x = pk2(v[0], v[1]); w.y = pk2(v[2], v[3]); w.z = pk2(v[4], v[5]); w.w = pk2(v[6], v[7]);
            *(u32x4*)(EM + ((size_t)(g * 256 + row)) * 1024 + c0) = w; }
    }
    __syncthreads();
}

__device__ __forceinline__ void put_hin(bf16_t* U2, int g, int cr, int p, float hr, float hi) {
    bf16_t* d = U2 + (size_t)(g * U2_ROWS + cr) * U2_LD + 1024 + p;
    const unsigned rh = f2bf(hr), ih = f2bf(hi);
    const float rl = hr - __builtin_bit_cast(float, rh << 16), il = hi - __builtin_bit_cast(float, ih << 16);
    d[0] = (bf16_t)rh; d[64] = (bf16_t)ih; d[128] = (bf16_t)f2bf(rl); d[192] = (bf16_t)f2bf(il);
}
__device__ __forceinline__ void carry_phase(CArgs a, int l, LAS unsigned char* lds, int tid, int lane, int wave, int G, int bx) {
    bf16_t* U2 = (bf16_t*)(a->ws + WS_U2); const float* E = (const float*)(a->ws + WS_E); const float* A64 = (const float*)(a->ws + WS_A64);
    LAS float* SE = (LAS float*)lds;
    for (int it = bx; it < 192; it += G) {
        if (it < 64) {
            const int b = it >> 5, g = it & 31, p = lane, seg = wave;
            const float ar = A64[(g * 64 + p) * 2], ai = A64[(g * 64 + p) * 2 + 1];
            float er[32], ei[32];
#pragma unroll
            for (int k = 0; k < 32; ++k) { const size_t ro = (size_t)(g * U2_ROWS + b * 256 + seg * 32 + k) * 256; er[k] = E[ro + p]; ei[k] = E[ro + 64 + p]; }
            float hr = 0.f, hi = 0.f;
#pragma unroll
            for (int k = 0; k < 32; ++k) { const float nr = ar * hr - ai * hi + er[k], ni = ar * hi + ai * hr + ei[k]; hr = nr; hi = ni; }
            __syncthreads();
            SE[(seg * 64 + p) * 2] = hr; SE[(seg * 64 + p) * 2 + 1] = hi;
            __syncthreads();
            float br = ar, bi = ai;
#pragma unroll
            for (int q = 0; q < 5; ++q) { const float nr = br * br - bi * bi, ni = 2.f * br * bi; br = nr; bi = ni; }
            float cr_ = 0.f, ci_ = 0.f;
            for (int s2 = 0; s2 < seg; ++s2) { const float sr = SE[(s2 * 64 + p) * 2], si = SE[(s2 * 64 + p) * 2 + 1]; const float nr = br * cr_ - bi * ci_ + sr, ni = br * ci_ + bi * cr_ + si; cr_ = nr; ci_ = ni; }
            hr = cr_; hi = ci_;
#pragma unroll
            for (int k = 0; k < 32; ++k) { put_hin(U2, g, b * 256 + seg * 32 + k, p, hr, hi);
                const float nr = ar * hr - ai * hi + er[k], ni = ar * hi + ai * hr + ei[k]; hr = nr; hi = ni; }
            if (seg == 7) { a->out[O_SRP + (size_t)((l * 2 + b) * 32 + g) * 64 + p] = hr; a->out[O_SIP + (size_t)((l * 2 + b) * 32 + g) * 64 + p] = hi; }
        } else {
            const int idx = it - 64, sb = idx >> 2, g = (idx & 3) * 8 + wave, p = lane;
            const float ar = A64[(g * 64 + p) * 2], ai = A64[(g * 64 + p) * 2 + 1];
            const size_t so = (size_t)((l * 32 + sb) * 32 + g) * 64 + p;
            const float hr = a->in[4][so], hi = a->in[5][so];
            put_hin(U2, g, 512 + sb, p, hr, hi);
            const size_t ro = (size_t)(g * U2_ROWS + 512 + sb) * 256;
            a->out[O_SRS + so] = ar * hr - ai * hi + E[ro + p]; a->out[O_SIS + so] = ar * hi + ai * hr + E[ro + 64 + p];
        }
    }
    __syncthreads();
}

__device__ __forceinline__ void conv_phase(CArgs a, int l, int lane, int gw, int NGW) {
    const bf16_t* PROJ = (const bf16_t*)(a->ws + WS_PROJ); bf16_t* YC = (bf16_t*)(a->ws + WS_XN);
    const int ch = lane * 8;
    float w0[8], w1[8], w2[8], og[8];
#pragma unroll
    for (int k = 0; k < 8; ++k) { const float* cw = a->in[25] + (size_t)(l * 512 + ch + k) * 3; w0[k] = cw[0]; w1[k] = cw[1]; w2[k] = cw[2]; og[k] = a->in[26][l * D + 1536 + ch + k]; }
#pragma unroll 2
    for (int tok = gw; tok < T; tok += NGW) {
        const bool pr = tok < TP; const int tl = pr ? (tok & (SEQ - 1)) : ((tok - TP) & 63); const int sb = pr ? 0 : ((tok - TP) >> 6);
        float z[3][8];
#pragma unroll
        for (int k = 0; k < 3; ++k) {
            if (tl - k >= 0) { const bf16_t* r = PROJ + (size_t)(tok - k) * NPJ; float gc[8], xc[8]; unpack8(*(const u32x4*)(r + PJ_GC + ch), gc); unpack8(*(const u32x4*)(r + PJ_XC + ch), xc);
#pragma unroll
                for (int j = 0; j < 8; ++j) z[k][j] = gc[j] * xc[j];
            } else if (pr) {
#pragma unroll
                for (int j = 0; j < 8; ++j) z[k][j] = 0.f;
            } else { const float* cb = a->in[6] + (size_t)((l * 32 + sb) * 2 + (tl - k + 2)) * 512 + ch; const f32x4 c0 = *(const f32x4*)cb, c1 = *(const f32x4*)(cb + 4);
#pragma unroll
                for (int j = 0; j < 4; ++j) { z[k][j] = c0[j]; z[k][4 + j] = c1[j]; } }
        }
        float gb[8]; unpack8(*(const u32x4*)(PROJ + (size_t)tok * NPJ + PJ_GB + ch), gb);
        float y[8], ss = 0.f;
#pragma unroll
        for (int j = 0; j < 8; ++j) { y[j] = gb[j] * (w0[j] * z[2][j] + w1[j] * z[1][j] + w2[j] * z[0][j]); ss += y[j] * y[j]; }
        const float rs = rsqrtf(wave_sum(ss) * (1.0f / 512.0f) + EPS);
        u32x4 w; w.x = pk2(y[0] * rs * og[0], y[1] * rs * og[1]); w.y = pk2(y[2] * rs * og[2], y[3] * rs * og[3]); w.z = pk2(y[4] * rs * og[4], y[5] * rs * og[5]); w.w = pk2(y[6] * rs * og[6], y[7] * rs * og[7]);
        *(u32x4*)(YC + (size_t)tok * D + 1536 + ch) = w;
        const int last = pr ? SEQ - 2 : 62;
        if (tl >= last) { float* dst = pr ? a->out + O_NCP + (size_t)((l * 2 + (tok >> 14)) * 2 + (tl - last)) * 512 + ch : a->out + O_NCS + (size_t)((l * 32 + sb) * 2 + (tl - last)) * 512 + ch;
            *(f32x4*)dst = (f32x4){z[0][0], z[0][1], z[0][2], z[0][3]}; *(f32x4*)(dst + 4) = (f32x4){z[0][4], z[0][5], z[0][6], z[0][7]}; }
    }
}
__device__ __forceinline__ void ssmnorm_phase(CArgs a, int l, int lane, int gw, int NGW) {
    const float* YT = (const float*)(a->ws + WS_YT); bf16_t* YC = (bf16_t*)(a->ws + WS_XN);
    const int ch = lane * 8; const f32x4 g0 = *(const f32x4*)(a->in[26] + l * D + ch), g1 = *(const f32x4*)(a->in[26] + l * D + ch + 4);
#pragma unroll 2
    for (int tok = gw; tok < T; tok += NGW) {
        const f32x4 v0 = *(const f32x4*)(YT + (size_t)tok * 512 + ch), v1 = *(const f32x4*)(YT + (size_t)tok * 512 + ch + 4);
        float ss = (v0[0] * v0[0] + v0[1] * v0[1]) + (v0[2] * v0[2] + v0[3] * v0[3]) + (v1[0] * v1[0] + v1[1] * v1[1]) + (v1[2] * v1[2] + v1[3] * v1[3]);
        const float rs = rsqrtf(wave_sum(ss) * (1.0f / 512.0f) + EPS);
        const f32x4 o0 = v0 * rs * g0, o1 = v1 * rs * g1;
        u32x4 w; w.x = pk2(o0[0], o0[1]); w.y = pk2(o0[2], o0[3]); w.z = pk2(o1[0], o1[1]); w.w = pk2(o1[2], o1[3]);
        *(u32x4*)(YC + (size_t)tok * D + ch) = w;
    }
}

constexpr int AT_KS = 0, AT_VT = 55296, AT_BL = 106496, AT_RED = 122880;
__device__ __forceinline__ int crow(int r, int h) { return (r & 3) + 8 * (r >> 2) + 4 * h; }
__device__ __forceinline__ void attn_phase(CArgs a, int l, LAS unsigned char* lds, int tid, int lane, int wave, int G, int bx) {
    const bf16_t* PROJ = (const bf16_t*)(a->ws + WS_PROJ); bf16_t* YC = (bf16_t*)(a->ws + WS_XN);
    LAS bf16_t* Ks = (LAS bf16_t*)(lds + AT_KS);
    LAS bf16_t* Vt = (LAS bf16_t*)(lds + AT_VT);
    LAS float* BL = (LAS float*)(lds + AT_BL);
    LAS float* RED = (LAS float*)(lds + AT_RED);
    const float* BLg = (const float*)(a->ws + WS_BIAS);
    for (int idx = tid; idx < 4096; idx += 512) BL[idx] = BLg[idx];
    const int ql = lane & 31, hf = lane >> 5;
    for (int it = (bx + 64) % G; it < 1088; it += G) {
        int ll = l; asm volatile("" : "+s"(ll));
        const bool pr = it < 1024; const int half = it & 1;
        const int bc = pr ? (it >> 1) : 0, c = bc & 255, b = bc >> 8, sb = pr ? 0 : ((it - 1024) >> 1);
        const int token0 = (pr ? bc * 64 : TP + sb * 64) + half * 32;
        __syncthreads();
        u32x4 rk[3][2], rv[3][2];
#pragma unroll
        for (int pass = 0; pass < 3; ++pass) {
            const int idx = tid + 512 * pass, row = idx >> 2, qd = idx & 3, kvh = row >= 192 ? 1 : 0, s = row - 192 * kvh, d0 = qd * 16;
            if (pr) { if ((c * 64 - 128 + s) >= 0) { const bf16_t* r = PROJ + (size_t)(bc * 64 - 128 + s) * NPJ;
                    rk[pass][0] = *(const u32x4*)(r + PJ_K + kvh * 64 + d0); rk[pass][1] = *(const u32x4*)(r + PJ_K + kvh * 64 + d0 + 8);
                    rv[pass][0] = *(const u32x4*)(r + PJ_V + kvh * 64 + d0); rv[pass][1] = *(const u32x4*)(r + PJ_V + kvh * 64 + d0 + 8); } }
            else if (s >= 128) { const bf16_t* r = PROJ + (size_t)(TP + sb * 64 + (s - 128)) * NPJ;
                rk[pass][0] = *(const u32x4*)(r + PJ_K + kvh * 64 + d0); rk[pass][1] = *(const u32x4*)(r + PJ_K + kvh * 64 + d0 + 8);
                rv[pass][0] = *(const u32x4*)(r + PJ_V + kvh * 64 + d0); rv[pass][1] = *(const u32x4*)(r + PJ_V + kvh * 64 + d0 + 8); }
        }
#pragma unroll
        for (int pass = 0; pass < 3; ++pass) {
            const int idx = tid + 512 * pass, row = idx >> 2, qd = idx & 3, kvh = row >= 192 ? 1 : 0, s = row - 192 * kvh, d0 = qd * 16;
            float kv[16], vv[16]; bool fromproj = false;
            if (pr) fromproj = (c * 64 - 128 + s) >= 0; else fromproj = s >= 128;
            if (fromproj) { unpack8(rk[pass][0], kv); unpack8(rk[pass][1], kv + 8); unpack8(rv[pass][0], vv); unpack8(rv[pass][1], vv + 8); }
            else if (!pr) { const size_t co = ((size_t)((ll * 32 + sb) * 128 + s) * 2 + kvh) * 64 + d0;
#pragma unroll
                for (int q = 0; q < 4; ++q) { const f32x4 k4 = *(const f32x4*)(a->in[2] + co + 4 * q), v4 = *(const f32x4*)(a->in[3] + co + 4 * q);
#pragma unroll
                    for (int j = 0; j < 4; ++j) { kv[4 * q + j] = k4[j]; vv[4 * q + j] = v4[j]; } }
            } else {
#pragma unroll
                for (int j = 0; j < 16; ++j) { kv[j] = 0.f; vv[j] = 0.f; } }
            float ss = 0.f;
#pragma unroll
            for (int j = 0; j < 16; ++j) ss += kv[j] * kv[j];
            ss += __shfl_xor(ss, 1); ss += __shfl_xor(ss, 2);
            if (fromproj) { const float rs = rsqrtf(ss * (1.0f / 64.0f) + EPS);
#pragma unroll
                for (int j = 0; j < 16; ++j) kv[j] = kv[j] * rs * a->in[23][ll * 64 + d0 + j]; }
            LAS bf16_t* kd = Ks + (kvh * 192 + s) * 72 + d0;
            u32x4 w0, w1; w0.x = pk2(kv[0], kv[1]); w0.y = pk2(kv[2], kv[3]); w0.z = pk2(kv[4], kv[5]); w0.w = pk2(kv[6], kv[7]);
            w1.x = pk2(kv[8], kv[9]); w1.y = pk2(kv[10], kv[11]); w1.z = pk2(kv[12], kv[13]); w1.w = pk2(kv[14], kv[15]);
            *(LAS u32x4*)kd = w0; *(LAS u32x4*)(kd + 8) = w1;
#pragma unroll
            for (int j = 0; j < 16; j += 2) { const unsigned pv = pk2(vv[j], vv[j + 1]); Vt[(kvh * 64 + d0 + j) * 200 + s] = (bf16_t)(pv & 0xffffu); Vt[(kvh * 64 + d0 + j + 1) * 200 + s] = (bf16_t)(pv >> 16); }
            int wrow = -1; float* nk = nullptr; float* nv = nullptr;
            if (half == 0) {
                if (pr) { if (c >= 254 && s >= 128) { wrow = (c - 254) * 64 + (s - 128); nk = a->out + O_NKP + (size_t)(l * 2 + b) * 128 * 128; nv = a->out + O_NVP + (size_t)(l * 2 + b) * 128 * 128; } }
                else if (s >= 64) { wrow = s - 64; nk = a->out + O_NKS + (size_t)(l * 32 + sb) * 128 * 128; nv = a->out + O_NVS + (size_t)(l * 32 + sb) * 128 * 128; }
            }
            if (wrow >= 0) { const size_t o = (size_t)wrow * 128 + kvh * 64 + d0;
#pragma unroll
                for (int q = 0; q < 4; ++q) { *(f32x4*)(nk + o + 4 * q) = (f32x4){kv[4 * q], kv[4 * q + 1], kv[4 * q + 2], kv[4 * q + 3]}; *(f32x4*)(nv + o + 4 * q) = (f32x4){vv[4 * q], vv[4 * q + 1], vv[4 * q + 2], vv[4 * q + 3]}; } }
        }
        const int kvh = wave >> 2, qtok = token0 + ql, qi = half * 32 + ql;
        u32x4 qraw[4];
#pragma unroll
        for (int st = 0; st < 4; ++st) qraw[st] = *(const u32x4*)(PROJ + (size_t)qtok * NPJ + (2 * wave) * 64 + st * 16 + hf * 8);
        __syncthreads();
        const int nmask = (pr && c < 2) ? 128 - 64 * c : 0;
        float ssq = 0.f;
#pragma unroll 1
        for (int hh = 0; hh < 2; ++hh) {
            const int h = 2 * wave + hh;
            bf16x8 qf[4];
            { float qv[4][8]; float ss = 0.f;
#pragma unroll
                for (int st = 0; st < 4; ++st) unpack8(qraw[st], qv[st]);
                if (hh == 0) {
#pragma unroll
                    for (int st = 0; st < 4; ++st) qraw[st] = *(const u32x4*)(PROJ + (size_t)qtok * NPJ + (h + 1) * 64 + st * 16 + hf * 8); }
#pragma unroll
                for (int st = 0; st < 4; ++st) {
#pragma unroll
                    for (int j = 0; j < 8; ++j) ss += qv[st][j] * qv[st][j]; }
                ss += __shfl_xor(ss, 32);
                const float rs = rsqrtf(ss * (1.0f / 64.0f) + EPS) * 0.125f;
#pragma unroll
                for (int st = 0; st < 4; ++st) { const float* qg = a->in[22] + ll * 64 + st * 16 + hf * 8; u32x4 w;
                    w.x = pk2(qv[st][0] * rs * qg[0], qv[st][1] * rs * qg[1]); w.y = pk2(qv[st][2] * rs * qg[2], qv[st][3] * rs * qg[3]);
                    w.z = pk2(qv[st][4] * rs * qg[4], qv[st][5] * rs * qg[5]); w.w = pk2(qv[st][6] * rs * qg[6], qv[st][7] * rs * qg[7]);
                    qf[st] = __builtin_bit_cast(bf16x8, w); } }
            const float sink = a->in[24][ll * 16 + h]; float mx = sink, sum = 0.f;
            const LAS float* blh = BL + h * 256 + 63 - qi;
            f32x16 o0, o1;
#pragma unroll
            for (int i = 0; i < 16; ++i) { o0[i] = 0.f; o1[i] = 0.f; }
#pragma unroll
            for (int ps = 0; ps < 6; ++ps) {
                asm volatile("" ::: "memory");
                float sv[1][16];
#pragma unroll
                for (int t3 = 0; t3 < 1; ++t3) { const int tt = ps + t3; f32x16 sa;
#pragma unroll
                    for (int i = 0; i < 16; ++i) sa[i] = 0.f;
#pragma unroll
                    for (int st = 0; st < 4; ++st) { const bf16x8 kf = *(const LAS bf16x8*)(Ks + (kvh * 192 + tt * 32 + ql) * 72 + st * 16 + hf * 8);
                        sa = __builtin_amdgcn_mfma_f32_32x32x16_bf16(kf, qf[st], sa, 0, 0, 0); }
#pragma unroll
                    for (int i = 0; i < 16; ++i) sv[t3][i] = sa[i]; }
                float mn = mx;
#pragma unroll
                for (int t3 = 0; t3 < 1; ++t3)
#pragma unroll
                    for (int i = 0; i < 16; ++i) { const int s = (ps + t3) * 32 + crow(i, hf); float v = sv[t3][i] + blh[s]; if (s < nmask) v = -1e30f; sv[t3][i] = v; mn = fmaxf(mn, v); }
                mn = fmaxf(mn, __shfl_xor(mn, 32));
                const float resc = __expf(mx - mn); mx = mn;
                float psum = 0.f;
#pragma unroll
                for (int t3 = 0; t3 < 1; ++t3)
#pragma unroll
                    for (int i = 0; i < 16; ++i) { const float p = __expf(sv[t3][i] - mx); sv[t3][i] = p; psum += p; }
                sum = sum * resc + psum;
                o0 = o0 * resc; o1 = o1 * resc;
#pragma unroll
                for (int t3 = 0; t3 < 1; ++t3)
#pragma unroll
                    for (int bb = 0; bb < 2; ++bb) { const int tt = ps + t3;
                        u32x4 pw; pw.x = pk2(sv[t3][8 * bb], sv[t3][8 * bb + 1]); pw.y = pk2(sv[t3][8 * bb + 2], sv[t3][8 * bb + 3]); pw.z = pk2(sv[t3][8 * bb + 4], sv[t3][8 * bb + 5]); pw.w = pk2(sv[t3][8 * bb + 6], sv[t3][8 * bb + 7]);
                        const bf16x8 pf = __builtin_bit_cast(bf16x8, pw);
                        const LAS bf16_t* v0p = Vt + (kvh * 64 + ql) * 200 + tt * 32 + 16 * bb + 4 * hf;
                        const LAS bf16_t* v1p = v0p + 32 * 200;
                        u32x4 a0, a1; { const u32x2 lo = *(const LAS u32x2*)v0p, hi = *(const LAS u32x2*)(v0p + 8); a0.x = lo.x; a0.y = lo.y; a0.z = hi.x; a0.w = hi.y; }
                        { const u32x2 lo = *(const LAS u32x2*)v1p, hi = *(const LAS u32x2*)(v1p + 8); a1.x = lo.x; a1.y = lo.y; a1.z = hi.x; a1.w = hi.y; }
                        o0 = __builtin_amdgcn_mfma_f32_32x32x16_bf16(__builtin_bit_cast(bf16x8, a0), pf, o0, 0, 0, 0);
                        o1 = __builtin_amdgcn_mfma_f32_32x32x16_bf16(__builtin_bit_cast(bf16x8, a1), pf, o1, 0, 0, 0);
                    }
            }
            sum += __shfl_xor(sum, 32);
            const float inv = 1.0f / (sum + __expf(sink - mx));
            o0 = o0 * inv; o1 = o1 * inv;
#pragma unroll
            for (int i = 0; i < 16; ++i) ssq += o0[i] * o0[i] + o1[i] * o1[i];
#pragma unroll
            for (int i4 = 0; i4 < 4; ++i4) { const int col = 512 + h * 64 + 8 * i4 + 4 * hf;
                u32x2 w; w.x = pk2(o0[4 * i4], o0[4 * i4 + 1]); w.y = pk2(o0[4 * i4 + 2], o0[4 * i4 + 3]); *(u32x2*)(YC + (size_t)qtok * D + col) = w;
                u32x2 w2; w2.x = pk2(o1[4 * i4], o1[4 * i4 + 1]); w2.y = pk2(o1[4 * i4 + 2], o1[4 * i4 + 3]); *(u32x2*)(YC + (size_t)qtok * D + col + 32) = w2; }
        }
        ssq += __shfl_xor(ssq, 32);
        if (lane < 32) RED[wave * 32 + ql] = ssq;
        asm volatile("s_waitcnt vmcnt(0)" ::: "memory");
        __syncthreads();
        float tot = 0.f;
#pragma unroll
        for (int w = 0; w < 8; ++w) tot += RED[w * 32 + ql];
        const float rs = rsqrtf(tot * (1.0f / 1024.0f) + EPS);
        { u32x2 yw[16]; bf16_t* yb = YC + (size_t)qtok * D + 512 + wave * 128 + 4 * hf;
#pragma unroll
          for (int k8 = 0; k8 < 16; ++k8) yw[k8] = *(const u32x2*)(yb + 8 * k8);
#pragma unroll
          for (int k8 = 0; k8 < 16; ++k8) { const f32x4 g4 = *(const f32x4*)(a->in[26] + ll * D + 512 + wave * 128 + 8 * k8 + 4 * hf);
              u32x2 w; w.x = pk2(bflo(yw[k8].x) * rs * g4[0], bfhi(yw[k8].x) * rs * g4[1]); w.y = pk2(bflo(yw[k8].y) * rs * g4[2], bfhi(yw[k8].y) * rs * g4[3]);
              *(u32x2*)(yb + 8 * k8) = w; } }
    }
    __syncthreads();
}


template <class Order>
__device__ __forceinline__ void reduce_tail(const Order& S, const float* PART, const float* gate, const XBuf xin, const XBuf xout, int lane, int wave, int G, int bx) {
    const int rows = 256 / S.split;
    for (int it = bx; it < (S.nwg - S.nfull) * S.split; it += G) { int pm, pn; S.tile_of(S.nfull + it / S.split, pm, pn);
        const int r0 = (it % S.split) * rows, c8 = (lane & 31) * 8;
        for (int rl = r0 + wave * 2 + (lane >> 5); rl < r0 + rows; rl += 16) { const int row = pm * 256 + rl, col = pn * 256 + c8;
            f32x4 s0 = {0.f, 0.f, 0.f, 0.f}, s1 = {0.f, 0.f, 0.f, 0.f};
            for (int p = 0; p < S.split; ++p) { const float* pp = PART + ((size_t)((it / S.split) * S.split + p) * 256 + rl) * 256 + c8; s0 += *(const f32x4*)pp; s1 += *(const f32x4*)(pp + 4); }
            const float* gp = gate + (size_t)batch_of(row) * NMOD + col; const f32x4 g0 = *(const f32x4*)gp, g1 = *(const f32x4*)(gp + 4);
            float xv[8], o[8]; xload8(xin, row, col, xv);
#pragma unroll
            for (int j = 0; j < 4; ++j) { o[j] = xv[j] + g0[j] * s0[j]; o[4 + j] = xv[4 + j] + g1[j] * s1[j]; }
            xstore8(xout, row, col, o); } }
}

#define XB_TMO      128
#define XB_XCNT(j)  (256  + 64 * (j))
#define XB_XSUB(j)  (1280 + 64 * (j))
#define XB_XGEN(j)  (2304 + 64 * (j))
#define XB_TOP      3328
#define XB_TOPGEN   3392
#define XCD_BAR_WORDS 3456
#define XB_SPIN_CAP (1u << 22)
__device__ __forceinline__ unsigned xb_ld(unsigned* p)              { return __hip_atomic_load(p, __ATOMIC_RELAXED, __HIP_MEMORY_SCOPE_AGENT); }
__device__ __forceinline__ unsigned xb_add(unsigned* p, unsigned v) { return __hip_atomic_fetch_add(p, v, __ATOMIC_RELAXED, __HIP_MEMORY_SCOPE_AGENT); }
__device__ __forceinline__ unsigned xb_xcc_id() { return (unsigned)__builtin_amdgcn_s_getreg((3 << 11) | 20) & 0xFu; }
#define XB_SPIN(cond, bar) do { unsigned _sp = 0; while (cond) { __builtin_amdgcn_s_sleep(1); \
    if ((++_sp & 255u) == 0u) { if (xb_ld(&(bar)[XB_TMO])) break; if (_sp > XB_SPIN_CAP) { atomicAdd(&(bar)[XB_TMO], 1u); break; } } } } while (0)
struct XcdBarrier { unsigned* bar; unsigned x; volatile LAS unsigned* st; };
__device__ __forceinline__ XcdBarrier xcd_barrier_post(unsigned* bar, volatile LAS unsigned* st) {
    XcdBarrier b; b.bar = bar; b.x = xb_xcc_id(); b.st = st;
    if (threadIdx.x == 0) (void)xb_add(&bar[XB_XCNT(b.x)], 1u);
    return b;
}
__device__ __forceinline__ void xcd_barrier_complete(unsigned* bar, unsigned x, unsigned& nloc, unsigned& nx) {
    const unsigned G = gridDim.x * gridDim.y * gridDim.z;
    unsigned sum, cnt, mine, sp = 0u;
    for (;;) {
        sum = 0u; cnt = 0u; mine = 0u;
#pragma unroll
        for (unsigned j = 0; j < 16; ++j) { const unsigned c = xb_ld(&bar[XB_XCNT(j)]); sum += c; cnt += (c > 0u) ? 1u : 0u; mine = (j == x) ? c : mine; }
        if (sum == G) break;
        __builtin_amdgcn_s_sleep(1);
        if ((++sp & 255u) == 0u) { if (xb_ld(&bar[XB_TMO])) break; if (sp > XB_SPIN_CAP) { atomicAdd(&bar[XB_TMO], 1u); break; } }
    }
    nloc = mine > 0u ? mine : 1u; nx = cnt > 0u ? cnt : 1u;
}
__device__ __forceinline__ void xcd_barrier(const XcdBarrier& b, const int tid) {
    asm volatile("s_waitcnt vmcnt(0)" ::: "memory");
    __syncthreads();
    if (tid == 0) {
        unsigned* bar = b.bar;
        __builtin_amdgcn_s_waitcnt(0);
        unsigned nloc = b.st[0], nx = b.st[1];
        if (nloc == 0u) { xcd_barrier_complete(bar, b.x, nloc, nx); b.st[0] = nloc; b.st[1] = nx; }
        const unsigned old = xb_add(&bar[XB_XSUB(b.x)], 1u);
        const unsigned gen = old / nloc;
        if (old + 1u == (gen + 1u) * nloc) {
            __builtin_amdgcn_fence(__ATOMIC_RELEASE, "agent");
            asm volatile("s_waitcnt vmcnt(0)" ::: "memory");
            const unsigned og = xb_add(&bar[XB_TOP], 1u);
            const unsigned tg = og / nx;
            if (og + 1u == (tg + 1u) * nx) xb_add(&bar[XB_TOPGEN], 1u);
            else XB_SPIN(xb_ld(&bar[XB_TOPGEN]) == tg, bar);
            __builtin_amdgcn_fence(__ATOMIC_ACQUIRE, "agent");
            xb_add(&bar[XB_XGEN(b.x)], 1u);
            asm volatile("s_waitcnt vmcnt(0)" ::: "memory");
        } else {
            XB_SPIN(xb_ld(&bar[XB_XGEN(b.x)]) == gen, bar);
            __builtin_amdgcn_fence(__ATOMIC_ACQUIRE, "agent");
            asm volatile("s_waitcnt vmcnt(0)" ::: "memory");
        }
    }
    __syncthreads();
}
constexpr int LDS_ST_OFF = LDS_BYTES - 64;

__global__ void __launch_bounds__(512, 2) mega(Args a_) {
    extern __shared__ __attribute__((aligned(16))) unsigned char lds_raw[];
    LAS unsigned char* lds = (LAS unsigned char*)lds_raw;
    cg::grid_group grid = cg::this_grid();
    const int ph_lo = a_.ph_lo, ph_hi = a_.ph_hi; int rep = 0; (void)rep;
    volatile LAS unsigned* bst = (volatile LAS unsigned*)(lds + LDS_ST_OFF);
    if (threadIdx.x < 2) bst[threadIdx.x] = 0u;
    __syncthreads();
    const XcdBarrier xbar = xcd_barrier_post((unsigned*)a_.ws, bst);
    const int wave0 = __builtin_amdgcn_readfirstlane((int)(threadIdx.x >> 6));
    for (int ph = ph_lo; ph < ph_hi; ++ph) {
        unsigned zz = 0u; asm volatile("" : "+v"(zz)); int w0 = wave0; asm volatile("" : "+s"(w0));
        int tid = w0 * 64 + (int)__builtin_amdgcn_mbcnt_hi(~0u, __builtin_amdgcn_mbcnt_lo(~0u, zz));
        int bx = blockIdx.x, G = gridDim.x; asm volatile("" : "+s"(bx), "+s"(G));
        CArgs a = (CArgs)__builtin_amdgcn_kernarg_segment_ptr(); asm volatile("" : "+s"(a));
        const int lane = tid & 63, wave = __builtin_amdgcn_readfirstlane(tid >> 6);
        const int gw = bx * 8 + wave, NGW = G * 8;
        unsigned char* ws = a->ws;
        bf16_t* XN = (bf16_t*)(ws + WS_XN);
        if (ph == 0) phase0(a, lds, tid, lane, wave, G, bx);
        else {
            const int l = (ph - 1) / 11, sp = (ph - 1) % 11;
            const float* MODl = (const float*)(ws + WS_MOD) + (size_t)l * NB * NMOD;
            unsigned char* wl = ws + WS_W + (size_t)l * WPL;
            const unsigned char* ob = (const unsigned char*)a->out;
            const XBuf X0{(const unsigned char*)a->in[0], (const unsigned char*)a->in[1] - (size_t)TP * 8192, TP, 1};
            const XBuf XA{ob, ob, 0, 0}, XB{ob + (size_t)T * 4096, ob + (size_t)T * 4096, 0, 0};
            const XBuf XC{ws + 956 * MiB, ws + WS_MT - (size_t)17408 * 4096, 17408, 0}, XY{ob, ob, 0, 1};
            const XBuf xin1 = l == 0 ? X0 : XB;
            const XBuf xmid = l == 0 ? XA : XC;
            const XBuf xend = l == 0 ? XB : XY;
            if (sp == 0) { ssm_build(a, l, lds, tid, G, bx); rownorm_phase(xin1, MODl, MODl + 2048, XN, lane, gw, NGW); }
            else if (sp == 1) { pg8::Gemm g{XN, (const bf16_t*)(wl + W_IN), D, D, D}; pg8::StaticOrder S; S.init(T, NIN, D, G, bx);
                pg8::EpiIn E{(bf16_t*)(ws + WS_U2), (bf16_t*)(ws + WS_PROJ)}; pg8::gemm_phase(lds, tid, g, S, E); }
            else if (sp == 2) { pg8::Gemm g{(const bf16_t*)(ws + WS_U2), (const bf16_t*)(ws + WS_EM), U2_LD, 1024, 1024}; pg8::S1Order S{G, bx};
                pg8::EpiS1 E{(float*)(ws + WS_E)}; pg8::gemm_phase(lds, tid, g, S, E);
                attn_phase(a, l, lds, tid, lane, wave, G, bx);
                conv_phase(a, l, lane, gw, NGW); }
            else if (sp == 3) carry_phase(a, l, lds, tid, lane, wave, G, bx);
            else if (sp == 4) { pg8::Gemm g{(const bf16_t*)(ws + WS_U2), (const bf16_t*)(ws + WS_MT), U2_LD, U2_LD, U2_LD}; pg8::EpiS2 E{(bf16_t*)(ws + WS_YG)};
                if (G == 256) { pg8::S2XcdOrder S{G, bx}; pg8::gemm_phase(lds, tid, g, S, E);
                    if (l == 0 && bx >= 128) transpose_weights(a, lds, TR_ITEMS / 2, TR_ITEMS / 2 + 800, lane, wave, bx - 128, 128); }
                else { pg8::S2Order S{G, bx}; pg8::gemm_phase(lds, tid, g, S, E); } }
            else if (sp == 5) { pg8::Gemm g{(const bf16_t*)(ws + WS_YG), (const bf16_t*)(wl + W_GLU), 512, 512, 512};
                if (G >= T / 256) {
                    LAS float* rss = (LAS float*)(lds + 131072);
                    if (tid < 256) rss[tid] = 0.f;
                    __syncthreads();
                    pg8::GluOrder S{G, bx}; pg8::EpiGlu2 E{(const bf16_t*)(ws + WS_YG), XN, rss}; pg8::gemm_phase(lds, tid, g, S, E);
                    __syncthreads();
                    if (G == 256 && l == 0 && bx >= T / 256) transpose_weights(a, lds, TR_ITEMS / 2 + 800, TR_ITEMS, lane, wave, bx - T / 256, G - T / 256);
                    if (bx < T / 256) { const int wr = wave >> 2, wc = wave & 3, fr = lane & 15, fq = lane >> 4;
#pragma unroll 1
                        for (int pn = 0; pn < 2; ++pn)
#pragma unroll 1
                            for (int bj = 0; bj < 2; ++bj) { const int col = pn * 256 + wc * 32 + 8 * fq + bj * 128;
                                const f32x4 g0 = *(const f32x4*)(a->in[26] + l * D + col), g1 = *(const f32x4*)(a->in[26] + l * D + col + 4);
#pragma unroll
                                for (int am = 0; am < 8; ++am) { const int rl = wr * 64 + fr + (am >> 2) * 128 + (am & 3) * 16; bf16_t* yp = XN + ((size_t)bx * 256 + rl) * D + col;
                                    const float rs = rsqrtf(rss[rl] * (1.0f / 512.0f) + EPS); float y[8]; unpack8(*(const u32x4*)yp, y);
                                    u32x4 w; w.x = pk2(y[0] * rs * g0[0], y[1] * rs * g0[1]); w.y = pk2(y[2] * rs * g0[2], y[3] * rs * g0[3]); w.z = pk2(y[4] * rs * g1[0], y[5] * rs * g1[1]); w.w = pk2(y[6] * rs * g1[2], y[7] * rs * g1[3]);
                                    *(u32x4*)yp = w; } } }
                } else { pg8::StaticOrder S; S.init(T, 512, 512, G, bx);
                    pg8::EpiGlu E{(const bf16_t*)(ws + WS_YG), (float*)(ws + WS_YT)}; pg8::gemm_phase(lds, tid, g, S, E); } }
            else if (sp == 6) { if (G < T / 256) ssmnorm_phase(a, l, lane, gw, NGW); }
            else if (sp == 7 || sp == 10) { const bool o = sp == 7;
                pg8::Gemm g{o ? XN : (const bf16_t*)(ws + WS_HID), (const bf16_t*)(wl + (o ? W_OUT : W_FF2)), o ? D : DFF, o ? D : DFF, o ? D : DFF};
                pg8::StaticOrder S; S.init(T, D, o ? D : DFF, G, bx, true);
                float* PART = (float*)(ws + (o ? WS_HID : WS_XN));
                pg8::EpiRes E{o ? xin1 : xmid, o ? xmid : xend, MODl + (o ? 4096 : 10240), (o ? D : DFF) / 64, PART}; pg8::gemm_phase(lds, tid, g, S, E);
                if (S.split > 1) { xcd_barrier(xbar, tid); reduce_tail(S, PART, MODl + (o ? 4096 : 10240), o ? xin1 : xmid, o ? xmid : xend, lane, wave, G, bx); } }
            else if (sp == 8) rownorm_phase(xmid, MODl + 6144, MODl + 8192, XN, lane, gw, NGW);
            else if (sp == 9) { pg8::Gemm g{XN, (const bf16_t*)(wl + W_FF1), D, D, D}; pg8::EpiFF1 E{(bf16_t*)(ws + WS_HID)};
                if (G == 256) { pg8::FF1Order S{G, bx}; pg8::gemm_phase(lds, tid, g, S, E); }
                else { pg8::StaticOrder S; S.init(T, DFF, D, G, bx); pg8::gemm_phase(lds, tid, g, S, E); } }
        }
        if (ph + 1 < ph_hi && !(ph > 0 && (ph - 1) % 11 == 6 && G >= T / 256)) { if (ph < 0) grid.sync(); else xcd_barrier(xbar, tid); }
#if defined(REP_SYNC)
        xcd_barrier(xbar, tid);
#endif
#if defined(REP_MASK)
        { const int spx = ph == 0 ? 11 : (ph - 1) % 11;
          if (((REP_MASK >> spx) & 1) && !rep) { rep = 1; --ph; } else rep = 0; }
#endif
    }
}

extern "C" void kernel_launch(void* const* d_in, const int* in_sizes, int n_in, void* d_out, int out_size, void* d_ws, size_t ws_size, hipStream_t stream) {
    static int grid = 0;
    if (grid == 0) {
        if (n_in != 30 || (size_t)out_size != O_END || ws_size < WS_END) { fprintf(stderr, "kernel_launch: unexpected shapes: n_in %d out %d (want %zu) ws %zu (want %zu)\n", n_in, out_size, (size_t)O_END, ws_size, (size_t)WS_END); grid = -1; return; }
        int dev = 0, cus = 0, per_cu = 0;
        hipGetDevice(&dev); hipDeviceGetAttribute(&cus, hipDeviceAttributeMultiprocessorCount, dev);
        if (hipFuncSetAttribute((const void*)mega, hipFuncAttributeMaxDynamicSharedMemorySize, LDS_BYTES) != hipSuccess) { fprintf(stderr, "kernel_launch: hipFuncSetAttribute failed\n"); grid = -1; return; }
        if (hipOccupancyMaxActiveBlocksPerMultiprocessor(&per_cu, (const void*)mega, 512, LDS_BYTES) != hipSuccess || per_cu < 1) { fprintf(stderr, "kernel_launch: occupancy query says %d\n", per_cu); per_cu = 1; }
        (void)hipGetLastError();
        grid = cus * per_cu;
    }
    if (grid < 0) return;
    if (hipMemsetAsync(d_ws, 0, 16384, stream) != hipSuccess) { fprintf(stderr, "kernel_launch: memset of the barrier words failed\n"); return; }
    Args a{};
    for (int i = 0; i < 30; ++i) a.in[i] = (const float*)d_in[i];
    a.out = (float*)d_out; a.ws = (unsigned char*)d_ws; a.ph_lo = 0; a.ph_hi = NPH;
    void* args[] = {&a};
    const hipError_t e = hipLaunchCooperativeKernel((const void*)mega, dim3(grid), dim3(512), args, LDS_BYTES, stream);
    if (e != hipSuccess) fprintf(stderr, "kernel_launch: cooperative launch failed: %s (grid %d)\n", hipGetErrorString(e), grid);
}
```

```cpp
#include <hip/hip_runtime.h>
#include <hip/hip_cooperative_groups.h>
#include <cstdio>
namespace cg = cooperative_groups;

#define LAS __attribute__((address_space(3)))
typedef unsigned short bf16_t;
typedef short bf16x8 __attribute__((ext_vector_type(8)));
typedef float f32x4 __attribute__((ext_vector_type(4)));
typedef float f32x2 __attribute__((ext_vector_type(2)));
typedef float f32x16 __attribute__((ext_vector_type(16)));
typedef unsigned u32x4 __attribute__((ext_vector_type(4)));
typedef unsigned u32x2 __attribute__((ext_vector_type(2)));

constexpr int D = 2048, TP = 32768, TS = 2048, T = TP + TS, SEQ = 16384, NIN = 3328, NPJ = 2816, DFF = 8192, NB = 34, NMOD = 12288;
constexpr int PJ_K = 1024, PJ_V = 1152, PJ_GB = 1280, PJ_GC = 1792, PJ_XC = 2304;
constexpr int U2_ROWS = 768, U2_LD = 1280;
constexpr float EPS = 1e-6f;
constexpr size_t O_Y = 0;
constexpr size_t O_NKP = (size_t)T * D;
constexpr size_t O_NVP = O_NKP + 2 * 2 * 128 * 128;
constexpr size_t O_SRP = O_NVP + 2 * 2 * 128 * 128;
constexpr size_t O_SIP = O_SRP + 2 * 2 * 32 * 64;
constexpr size_t O_NCP = O_SIP + 2 * 2 * 32 * 64;
constexpr size_t O_NKS = O_NCP + 2 * 2 * 2 * 512;
constexpr size_t O_NVS = O_NKS + (size_t)2 * 32 * 128 * 128;
constexpr size_t O_SRS = O_NVS + (size_t)2 * 32 * 128 * 128;
constexpr size_t O_SIS = O_SRS + 2 * 32 * 32 * 64;
constexpr size_t O_NCS = O_SIS + 2 * 32 * 32 * 64;
constexpr size_t O_END = O_NCS + 2 * 32 * 2 * 512;
constexpr size_t MiB = 1u << 20;
constexpr size_t WS_BIAS = 1 * MiB;
constexpr size_t WS_A64 = 1 * MiB + 65536;
constexpr size_t WS_MOD = 2 * MiB;
constexpr size_t WS_W = 8 * MiB;
constexpr size_t WPL = 85 * MiB + MiB / 2;
constexpr size_t W_IN = 0, W_OUT = 13 * MiB, W_FF1 = 21 * MiB, W_FF2 = 53 * MiB, W_GLU = 85 * MiB;
constexpr size_t WS_MT = 180 * MiB;
constexpr size_t WS_EM = 260 * MiB;
constexpr size_t WS_XN = 276 * MiB;
constexpr size_t WS_HID = 412 * MiB;
constexpr size_t WS_PROJ = 412 * MiB;
constexpr size_t WS_U2 = 599 * MiB;
constexpr size_t WS_E = 659 * MiB;
constexpr size_t WS_YG = 683 * MiB;
constexpr size_t WS_YT = 717 * MiB;
constexpr size_t WS_END = 1024 * MiB;
constexpr int LDS_BYTES = 147456;
constexpr int NPH = 23;
#ifndef TR_HEAD
#define TR_HEAD 0
#endif
#ifndef AUX_FF2A
#define AUX_FF2A 0
#endif

struct Args { const float* in[30]; float* out; unsigned char* ws; int ph_lo, ph_hi; };
typedef const __attribute__((address_space(4))) Args* CArgs;

__device__ __forceinline__ unsigned f2bf(float f) { unsigned u = __builtin_bit_cast(unsigned, f); return (u + 0x7fffu + ((u >> 16) & 1u)) >> 16; }
typedef __bf16 bf16x2_t __attribute__((ext_vector_type(2)));
__device__ __forceinline__ unsigned pk2(float lo, float hi) { const f32x2 v = {lo, hi}; return __builtin_bit_cast(unsigned, __builtin_convertvector(v, bf16x2_t)); }
__device__ __forceinline__ float bflo(unsigned u) { return __builtin_bit_cast(float, u << 16); }
__device__ __forceinline__ float bfhi(unsigned u) { return __builtin_bit_cast(float, u & 0xffff0000u); }
__device__ __forceinline__ void unpack8(u32x4 w, float* f) { f[0] = bflo(w.x); f[1] = bfhi(w.x); f[2] = bflo(w.y); f[3] = bfhi(w.y); f[4] = bflo(w.z); f[5] = bfhi(w.z); f[6] = bflo(w.w); f[7] = bfhi(w.w); }
__device__ __forceinline__ float wave_sum(float v) {
#pragma unroll
    for (int o = 1; o < 64; o <<= 1) v += __shfl_xor(v, o);
    return v;
}
__device__ __forceinline__ int batch_of(int row) { return row < TP ? (row >> 14) : 2 + ((row - TP) >> 6); }
__device__ __forceinline__ float gelu_tanh(float x) { const float u = 0.7978845608028654f * (x + 0.044715f * x * x * x); return x / (1.0f + __expf(-2.0f * u)); }


struct XBuf { const unsigned char* p0; const unsigned char* p1; int split; int f32; };
__device__ __forceinline__ const unsigned char* xrow(const XBuf& b, int row) { return (row < b.split ? b.p0 : b.p1) + (size_t)row * (b.f32 ? 8192 : 4096); }
__device__ __forceinline__ void xload8(const XBuf& b, int row, int col, float* v) {
    const unsigned char* r = xrow(b, row);
    if (b.f32) { const f32x4 a0 = *(const f32x4*)(r + (size_t)col * 4), a1 = *(const f32x4*)(r + (size_t)col * 4 + 16);
#pragma unroll
        for (int j = 0; j < 4; ++j) { v[j] = a0[j]; v[4 + j] = a1[j]; } }
    else unpack8(*(const u32x4*)(r + (size_t)col * 2), v);
}
__device__ __forceinline__ void xstore8(const XBuf& b, int row, int col, const float* v) {
    unsigned char* r = (unsigned char*)xrow(b, row);
    if (b.f32) { *(f32x4*)(r + (size_t)col * 4) = (f32x4){v[0], v[1], v[2], v[3]}; *(f32x4*)(r + (size_t)col * 4 + 16) = (f32x4){v[4], v[5], v[6], v[7]}; }
    else { u32x4 w; w.x = pk2(v[0], v[1]); w.y = pk2(v[2], v[3]); w.z = pk2(v[4], v[5]); w.w = pk2(v[6], v[7]); *(u32x4*)(r + (size_t)col * 2) = w; }
}

namespace pg8 {
constexpr int BM = 256, BK = 64, HALF = 128, HTB = HALF * BK * 2, STAGE_BYTES = 8 * HTB, NXCD = 8, WGM = 4;
__device__ __forceinline__ int lds_byte(int r, int c) { const int st = (r >> 4) * 2 + (c >> 5), rr = r & 15, cc = c & 31, ob = rr * 64 + cc * 2; return st * 1024 + (ob ^ (((ob >> 9) & 1) << 5)); }
__device__ __forceinline__ void stage_rc(int b, int& R, int& C) { const int st = b / 1024, sb = b % 1024, swz = sb ^ (((sb >> 9) & 1) << 5); R = (st >> 1) * 16 + swz / 64; C = (st & 1) * 32 + (swz % 64) / 2; }
__device__ __forceinline__ int perm32(int rho) { const int n = rho >> 4, i = rho & 15; return 8 * (i >> 2) + 4 * n + (i & 3); }
struct Unit { int pm, pn, k0, nt, tl; };
struct Gemm { const bf16_t* A; const bf16_t* Bt; int lda, ldb, K; };
struct StaticOrder {
    int nM, nN, nwg, G, c, ntf, nfull, split;
    __device__ __forceinline__ void init(int M, int N, int K, int G_, int c_, bool ksplit = false) { nM = M / BM; nN = N / BM; nwg = nM * nN; G = G_; c = c_; ntf = K / BK; nfull = nwg; split = 1;
        if (ksplit) { const int tail = nwg % G; if (tail > 0 && G % tail == 0 && (ntf % (2 * (G / tail))) == 0) { nfull = nwg - tail; split = G / tail; } } }
    __device__ __forceinline__ bool next(int i, Unit& u) const {
        const int L = i * G + c; int wgid, k0 = 0, nt = ntf, tl = -1;
        if (L < nfull) wgid = L;
        else { tl = L - nfull; if (tl >= (nwg - nfull) * split) return false; wgid = nfull + tl / split; nt = ntf / split; k0 = (tl % split) * nt * BK; }
        { const int q = nwg / NXCD, r = nwg % NXCD, xcd = wgid % NXCD, off = wgid / NXCD; wgid = (xcd < r ? xcd * (q + 1) : r * (q + 1) + (xcd - r) * q) + off; }
        const int nig = WGM * nN, gid = wgid / nig, fm = gid * WGM, gsz = (nM - fm) < WGM ? (nM - fm) : WGM;
        u.pm = fm + ((wgid % nig) % gsz); u.pn = (wgid % nig) / gsz; u.k0 = k0; u.nt = nt; u.tl = tl; return true;
    }
    __device__ __forceinline__ void tile_of(int wgid, int& pm, int& pn) const {
        { const int q = nwg / NXCD, r = nwg % NXCD, xcd = wgid % NXCD, off = wgid / NXCD; wgid = (xcd < r ? xcd * (q + 1) : r * (q + 1) + (xcd - r) * q) + off; }
        const int nig = WGM * nN, gid = wgid / nig, fm = gid * WGM, gsz = (nM - fm) < WGM ? (nM - fm) : WGM;
        pm = fm + ((wgid % nig) % gsz); pn = (wgid % nig) / gsz; }
};
struct FF1Order { int G, c;
    __device__ __forceinline__ bool next(int i, Unit& u) const { if (i >= 17) return false; const int xcd = c & 7, r = c >> 3; u.pm = 8 * i + (r & 7); u.pn = 4 * xcd + (r >> 3); u.k0 = 0; u.nt = 32; u.tl = -1; return true; } };
struct GluOrder { int G, c;
    __device__ __forceinline__ bool next(int i, Unit& u) const { const int pm = c + (i >> 1) * G; if (i > 1 || pm >= T / 256) return false; u.pm = pm; u.pn = i & 1; u.k0 = 0; u.nt = 8; u.tl = -1; return true; } };
struct S1Order { int G, c;
    __device__ __forceinline__ bool next(int i, Unit& u) const { const int L = i * G + c; if (L >= 96) return false; u.pm = L; u.pn = L / 3; u.k0 = 0; u.nt = 16; u.tl = -1; return true; } };
struct S2XcdOrder { int G, c;
    __device__ __forceinline__ bool next(int i, Unit& u) const { const int x = c & 7, u48 = (c >> 3) + 32 * i; if (i > 1 || u48 >= 48) return false;
        const int g = 4 * x + u48 / 12, r = u48 % 12; u.pm = g * 3 + (r >> 2); u.pn = g * 4 + (r & 3); u.k0 = 0; u.nt = 20; u.tl = -1; return true; } };
struct S2Order { int G, c;
    __device__ __forceinline__ bool next(int i, Unit& u) const { const int L = i * G + c; if (L >= 384) return false; const int g = L / 12, r = L % 12; u.pm = g * 3 + (r >> 2); u.pn = g * 4 + (r & 3); u.k0 = 0; u.nt = 20; u.tl = -1; return true; } };

template <int AUXA = 0, class Epi, class Sched>
__device__ __forceinline__ void gemm_phase(LAS unsigned char* lds, const int tid, const Gemm g, const Sched& S, const Epi& E) {
    const int wid = __builtin_amdgcn_readfirstlane(tid >> 6), lane = tid & 63, wr = wid >> 2, wc = wid & 3, fr = lane & 15, fq = lane >> 4;
    unsigned voffA[2], voffB[2];
#pragma unroll
    for (int i = 0; i < 2; ++i) { int R, C; stage_rc(tid * 16 + i * 8192, R, C); const int Rb = Epi::PERM ? ((R & ~31) + perm32(R & 31)) : R;
        voffA[i] = (unsigned)(R * g.lda + C) * 2u; voffB[i] = (unsigned)(Rb * g.ldb + C) * 2u; }
    const size_t kstep = (size_t)(BK * 2);
    const size_t hstepA = (size_t)HALF * g.lda * 2, hstepB = (size_t)HALF * g.ldb * 2;
    const size_t tstepA = 2 * hstepA, tstepB = 2 * hstepB;
    const unsigned ldsw = (unsigned)wid * 1024u;
    const int aoff = lds_byte(wr * 64 + fr, fq * 8), boff = lds_byte(wc * 32 + fr, fq * 8);
#define PG8_SA(b, h) (((b) * 2 + (h)) * HTB)
#define PG8_SB(b, h) ((4 + (b) * 2 + (h)) * HTB)
#define PG8_STAGE(bufoff, gbase, voff) do { _Pragma("unroll") for (int _i = 0; _i < 2; ++_i) \
        __builtin_amdgcn_global_load_lds((const unsigned*)((const char*)(gbase) + (voff)[_i]), (LAS unsigned*)(lds + (bufoff) + ldsw + _i * 8192), 16, 0, 0); } while (0)
#define PG8_STAGEA(bufoff, gbase, voff) do { _Pragma("unroll") for (int _i = 0; _i < 2; ++_i) \
        __builtin_amdgcn_global_load_lds((const unsigned*)((const char*)(gbase) + (voff)[_i]), (LAS unsigned*)(lds + (bufoff) + ldsw + _i * 8192), 16, 0, AUXA); } while (0)
#define PG8_LDA(dst, b, h) do { _Pragma("unroll") for (int m = 0; m < 4; ++m) _Pragma("unroll") for (int k = 0; k < 2; ++k) dst[m][k] = *(const LAS bf16x8*)(lds + PG8_SA(b, h) + aoff + m * 2048 + k * 1024); } while (0)
#define PG8_LDB(dst, b, h) do { _Pragma("unroll") for (int n = 0; n < 2; ++n) _Pragma("unroll") for (int k = 0; k < 2; ++k) dst[n][k] = *(const LAS bf16x8*)(lds + PG8_SB(b, h) + boff + n * 2048 + k * 1024); } while (0)
#define PG8_MMA(ai, bj, At, Bt) do { __builtin_amdgcn_s_setprio(1); _Pragma("unroll") for (int m = 0; m < 4; ++m) _Pragma("unroll") for (int n = 0; n < 2; ++n) _Pragma("unroll") for (int k = 0; k < 2; ++k) \
        acc[ai][bj][m][n] = __builtin_amdgcn_mfma_f32_16x16x32_bf16(Bt[n][k], At[m][k], acc[ai][bj][m][n], 0, 0, 0); __builtin_amdgcn_s_setprio(0); } while (0)
#define PG8_WAIT_V(n) asm volatile("s_waitcnt vmcnt(" #n ")" ::: "memory")
#define PG8_WAIT_L(n) asm volatile("s_waitcnt lgkmcnt(" #n ")" ::: "memory")
#define PG8_BAR __builtin_amdgcn_s_barrier()
#define PG8_SCHED __builtin_amdgcn_sched_barrier(0)
    Unit cur, nxt; int ui = 0;
    if (!S.next(0, cur)) return;
    f32x4 acc[2][2][4][2];
#pragma unroll
    for (int a = 0; a < 2; ++a)
#pragma unroll
        for (int b = 0; b < 2; ++b)
#pragma unroll
            for (int m = 0; m < 4; ++m)
#pragma unroll
                for (int n = 0; n < 2; ++n) acc[a][b][m][n] = (f32x4){0.f, 0.f, 0.f, 0.f};
    bf16x8 At[4][2], B0[2][2], B1[2][2];
    const char* cA = (const char*)g.A + (size_t)cur.pm * tstepA + (size_t)cur.k0 * 2; const char* cB = (const char*)g.Bt + (size_t)cur.pn * tstepB + (size_t)cur.k0 * 2;
    PG8_STAGE(PG8_SB(0, 0), cB, voffB); PG8_STAGE(PG8_SB(0, 1), cB + hstepB, voffB); PG8_STAGEA(PG8_SA(0, 0), cA, voffA); PG8_STAGEA(PG8_SA(0, 1), cA + hstepA, voffA);
    if (wr == 1) PG8_BAR;
    PG8_WAIT_V(2); PG8_BAR;
    PG8_STAGE(PG8_SB(1, 0), cB + kstep, voffB); PG8_STAGEA(PG8_SA(1, 0), cA + kstep, voffA); PG8_STAGE(PG8_SB(1, 1), cB + hstepB + kstep, voffB);
    PG8_WAIT_V(6); PG8_BAR;
    for (;;) {
        const bool has_next = S.next(ui + 1, nxt);
        const char* nA = has_next ? (const char*)g.A + (size_t)nxt.pm * tstepA + (size_t)nxt.k0 * 2 : cA; const char* nB = has_next ? (const char*)g.Bt + (size_t)nxt.pn * tstepB + (size_t)nxt.k0 * 2 : cB;
        const int nt = cur.nt;
        for (int t = 0; t < nt; t += 2) {
            const bool last = (t == nt - 2);
            const char* a1 = cA + (size_t)(t + 1) * kstep;
            const char* a2 = last ? nA : cA + (size_t)(t + 2) * kstep; const char* b2 = last ? nB : cB + (size_t)(t + 2) * kstep;
            const char* a3 = a2 + kstep; const char* b3 = b2 + kstep;
            PG8_LDB(B0, 0, 0); PG8_LDB(B1, 0, 1); PG8_SCHED; PG8_LDA(At, 0, 0); PG8_STAGEA(PG8_SA(1, 1), a1 + hstepA, voffA);
            PG8_WAIT_V(8); PG8_WAIT_L(0); PG8_BAR; PG8_MMA(0, 0, At, B0); PG8_MMA(0, 1, At, B1); PG8_BAR; PG8_SCHED;
            PG8_LDA(At, 0, 1); PG8_STAGE(PG8_SB(0, 0), b2, voffB); PG8_STAGE(PG8_SB(0, 1), b2 + hstepB, voffB); PG8_STAGEA(PG8_SA(0, 0), a2, voffA);
            PG8_WAIT_V(8); PG8_WAIT_L(0); PG8_BAR; PG8_MMA(1, 0, At, B0); PG8_MMA(1, 1, At, B1); PG8_BAR; PG8_SCHED;
            PG8_LDB(B0, 1, 0); PG8_LDB(B1, 1, 1); PG8_SCHED; PG8_LDA(At, 1, 0); PG8_STAGEA(PG8_SA(0, 1), a2 + hstepA, voffA);
            PG8_WAIT_V(8); PG8_WAIT_L(0); PG8_BAR; PG8_MMA(0, 0, At, B0); PG8_MMA(0, 1, At, B1); PG8_BAR; PG8_SCHED;
            PG8_LDA(At, 1, 1); PG8_STAGE(PG8_SB(1, 0), b3, voffB); PG8_STAGE(PG8_SB(1, 1), b3 + hstepB, voffB); PG8_STAGEA(PG8_SA(1, 0), a3, voffA);
            PG8_WAIT_V(8); PG8_WAIT_L(0); PG8_BAR; PG8_MMA(1, 0, At, B0); PG8_MMA(1, 1, At, B1); PG8_BAR; PG8_SCHED;
        }
        if (wr == 0) PG8_BAR;
        E(acc, cur, wr, wc, fr, fq);
        if (!has_next) break;
#pragma unroll
        for (int a = 0; a < 2; ++a)
#pragma unroll
            for (int b = 0; b < 2; ++b)
#pragma unroll
                for (int m = 0; m < 4; ++m)
#pragma unroll
                    for (int n = 0; n < 2; ++n) acc[a][b][m][n] = (f32x4){0.f, 0.f, 0.f, 0.f};
        cur = nxt; cA = nA; cB = nB; ++ui;
        if (wr == 1) PG8_BAR;
    }
    PG8_WAIT_V(0);
    PG8_BAR;
#undef PG8_SA
#undef PG8_SB
#undef PG8_STAGE
#undef PG8_STAGEA
#undef PG8_LDA
#undef PG8_LDB
#undef PG8_MMA
#undef PG8_WAIT_V
#undef PG8_WAIT_L
#undef PG8_BAR
#undef PG8_SCHED
}

__device__ __forceinline__ u32x4 pack8(f32x4 v0, f32x4 v1) { u32x4 w; w.x = pk2(v0[0], v0[1]); w.y = pk2(v0[2], v0[3]); w.z = pk2(v1[0], v1[1]); w.w = pk2(v1[2], v1[3]); return w; }

struct EpiIn {
    static constexpr bool PERM = true;
    bf16_t* U2; bf16_t* PROJ;
    __device__ __forceinline__ void operator()(const f32x4 (&acc)[2][2][4][2], const Unit& u, int wr, int wc, int fr, int fq) const {
        const int row0 = u.pm * BM + wr * 64 + fr, colb = u.pn * BM + wc * 32 + 8 * fq;
#pragma unroll
        for (int ai = 0; ai < 2; ++ai)
#pragma unroll
            for (int m = 0; m < 4; ++m) { const int row = row0 + ai * HALF + m * 16;
#pragma unroll
                for (int bj = 0; bj < 2; ++bj) { const int col = colb + bj * HALF; const u32x4 w = pack8(acc[ai][bj][m][0], acc[ai][bj][m][1]);
                    bf16_t* dst;
                    if (u.pn < 2) dst = U2 + ((size_t)((col >> 4) * U2_ROWS + (row >> 6)) * U2_LD + (row & 63) * 16 + (col & 15));
                    else dst = PROJ + (size_t)row * NPJ + (col - 512);
                    *(u32x4*)dst = w; } }
    }
};
struct EpiRes {
    static constexpr bool PERM = true;
    XBuf xin, xout; const float* gate; int ntf; float* part;
    __device__ __forceinline__ void operator()(const f32x4 (&acc)[2][2][4][2], const Unit& u, int wr, int wc, int fr, int fq) const {
        const int row0 = u.pm * BM + wr * 64 + fr, col0 = u.pn * BM + wc * 32 + 8 * fq;
        if (u.nt != ntf) {
#pragma unroll
            for (int ai = 0; ai < 2; ++ai)
#pragma unroll
                for (int m = 0; m < 4; ++m)
#pragma unroll
                    for (int bj = 0; bj < 2; ++bj) { float* pp = part + ((size_t)u.tl * 256 + (wr * 64 + fr + ai * HALF + m * 16)) * 256 + wc * 32 + 8 * fq + bj * HALF;
                        *(f32x4*)pp = acc[ai][bj][m][0]; *(f32x4*)(pp + 4) = acc[ai][bj][m][1]; }
            return; }
#pragma unroll
        for (int ai = 0; ai < 2; ++ai) {
            const int bi = batch_of(row0 + ai * HALF);
            f32x4 gv[2][2];
#pragma unroll
            for (int bj = 0; bj < 2; ++bj)
#pragma unroll
                for (int n = 0; n < 2; ++n) gv[bj][n] = *(const f32x4*)(gate + (size_t)bi * NMOD + col0 + bj * HALF + n * 4);
#pragma unroll
            for (int m = 0; m < 4; ++m) { const int row = row0 + ai * HALF + m * 16;
                float xv[2][8];
#pragma unroll
                for (int bj = 0; bj < 2; ++bj) xload8(xin, row, col0 + bj * HALF, xv[bj]);
#pragma unroll
                for (int bj = 0; bj < 2; ++bj) { float o[8];
#pragma unroll
                    for (int j = 0; j < 4; ++j) { o[j] = xv[bj][j] + gv[bj][0][j] * acc[ai][bj][m][0][j]; o[4 + j] = xv[bj][4 + j] + gv[bj][1][j] * acc[ai][bj][m][1][j]; }
                    xstore8(xout, row, col0 + bj * HALF, o); }
                if (m & 1) asm volatile("" ::: "memory"); }
        }
    }
};
struct EpiFF1 {
    static constexpr bool PERM = true;
    bf16_t* O;
    __device__ __forceinline__ void operator()(const f32x4 (&acc)[2][2][4][2], const Unit& u, int wr, int wc, int fr, int fq) const {
        const int row0 = u.pm * BM + wr * 64 + fr, col0 = u.pn * BM + wc * 32 + 8 * fq;
#pragma unroll
        for (int ai = 0; ai < 2; ++ai)
#pragma unroll
            for (int m = 0; m < 4; ++m) { bf16_t* rowp = O + (size_t)(row0 + ai * HALF + m * 16) * DFF + col0;
#pragma unroll
                for (int bj = 0; bj < 2; ++bj) { f32x4 v0 = acc[ai][bj][m][0], v1 = acc[ai][bj][m][1];
#pragma unroll
                    for (int j = 0; j < 4; ++j) { const float a0 = fmaxf(v0[j], 0.f), a1 = fmaxf(v1[j], 0.f); v0[j] = a0 * a0; v1[j] = a1 * a1; }
                    __builtin_nontemporal_store(pack8(v0, v1), (u32x4*)(rowp + bj * HALF)); } }
    }
};
struct EpiS1 {
    static constexpr bool PERM = false;
    float* Eo;
    __device__ __forceinline__ void operator()(const f32x4 (&acc)[2][2][4][2], const Unit& u, int wr, int wc, int fr, int fq) const {
        const int row0 = u.pm * BM + wr * 64 + fr, col0 = wc * 32 + 4 * fq;
#pragma unroll
        for (int ai = 0; ai < 2; ++ai)
#pragma unroll
            for (int m = 0; m < 4; ++m) { float* rowp = Eo + (size_t)(row0 + ai * HALF + m * 16) * 256 + col0;
#pragma unroll
                for (int bj = 0; bj < 2; ++bj)
#pragma unroll
                    for (int n = 0; n < 2; ++n) *(f32x4*)(rowp + bj * HALF + n * 16) = acc[ai][bj][m][n]; }
    }
};
struct EpiS2 {
    static constexpr bool PERM = true;
    bf16_t* YG;
    __device__ __forceinline__ void operator()(const f32x4 (&acc)[2][2][4][2], const Unit& u, int wr, int wc, int fr, int fq) const {
        const int g = u.pm / 3, i3 = u.pm - 3 * g, j4 = u.pn & 3;
        const int cr0 = i3 * BM + wr * 64 + fr, cb = j4 * BM + wc * 32 + 8 * fq;
#pragma unroll
        for (int ai = 0; ai < 2; ++ai)
#pragma unroll
            for (int m = 0; m < 4; ++m) { const int cr = cr0 + ai * HALF + m * 16;
                if (cr < 544) {
#pragma unroll
                    for (int bj = 0; bj < 2; ++bj) { const int c = cb + bj * HALF; f32x4 v0 = acc[ai][bj][m][0], v1 = acc[ai][bj][m][1];
#pragma unroll
                        for (int j = 0; j < 4; ++j) { v0[j] = gelu_tanh(v0[j]); v1[j] = gelu_tanh(v1[j]); }
                        *(u32x4*)(YG + (size_t)(cr * 64 + (c >> 4)) * 512 + g * 16 + (c & 15)) = pack8(v0, v1); } } }
    }
};
struct EpiGlu2 {
    static constexpr bool PERM = true;
    const bf16_t* YG; bf16_t* YC; LAS float* rss;
    __device__ __forceinline__ void operator()(const f32x4 (&acc)[2][2][4][2], const Unit& u, int wr, int wc, int fr, int fq) const {
        const int col0 = u.pn * BM + wc * 32 + 8 * fq;
#pragma unroll
        for (int ai = 0; ai < 2; ++ai)
#pragma unroll
            for (int m = 0; m < 4; ++m) { const int rl = wr * 64 + fr + ai * HALF + m * 16; const size_t row = (size_t)u.pm * BM + rl; float part = 0.f;
#pragma unroll
                for (int bj = 0; bj < 2; ++bj) { const int col = col0 + bj * HALF; const u32x4 yw = *(const u32x4*)(YG + row * 512 + col); float y[8], o[8]; unpack8(yw, y);
                    const f32x4 v0 = acc[ai][bj][m][0], v1 = acc[ai][bj][m][1];
#pragma unroll
                    for (int j = 0; j < 4; ++j) { o[j] = y[j] / (1.0f + __expf(-v0[j])); o[4 + j] = y[4 + j] / (1.0f + __expf(-v1[j])); }
#pragma unroll
                    for (int j = 0; j < 8; ++j) part += o[j] * o[j];
                    u32x4 w; w.x = pk2(o[0], o[1]); w.y = pk2(o[2], o[3]); w.z = pk2(o[4], o[5]); w.w = pk2(o[6], o[7]);
                    *(u32x4*)(YC + row * D + col) = w; }
                part += __shfl_xor(part, 16); part += __shfl_xor(part, 32);
                if (fq == 0) (void)__hip_atomic_fetch_add(rss + rl, part, __ATOMIC_RELAXED, __HIP_MEMORY_SCOPE_WORKGROUP); }
    }
};
struct EpiGlu {
    static constexpr bool PERM = true;
    const bf16_t* YG; float* YT;
    __device__ __forceinline__ void operator()(const f32x4 (&acc)[2][2][4][2], const Unit& u, int wr, int wc, int fr, int fq) const {
        const int row0 = u.pm * BM + wr * 64 + fr, col0 = u.pn * BM + wc * 32 + 8 * fq;
#pragma unroll
        for (int ai = 0; ai < 2; ++ai)
#pragma unroll
            for (int m = 0; m < 4; ++m) { const size_t ro = (size_t)(row0 + ai * HALF + m * 16) * 512 + col0;
#pragma unroll
                for (int bj = 0; bj < 2; ++bj) { const u32x4 yw = *(const u32x4*)(YG + ro + bj * HALF); float y[8]; unpack8(yw, y);
                    const f32x4 v0 = acc[ai][bj][m][0], v1 = acc[ai][bj][m][1]; f32x4 o0, o1;
#pragma unroll
                    for (int j = 0; j < 4; ++j) { o0[j] = y[j] / (1.0f + __expf(-v0[j])); o1[j] = y[4 + j] / (1.0f + __expf(-v1[j])); }
                    *(f32x4*)(YT + ro + bj * HALF) = o0; *(f32x4*)(YT + ro + bj * HALF + 4) = o1; } }
    }
};
}

__device__ __forceinline__ double SC(double c) { asm volatile("" : "+s"(c)); return c; }
__device__ __forceinline__ double dexp_(double x) {
    const double n = __builtin_rint(x * SC(1.4426950408889634));
    const double r = (x - n * SC(0.693147180369123816490)) - n * SC(1.90821492927058770002e-10);
    double p = SC(1.0 / 6227020800.0);
    p = p * r + SC(1.0 / 479001600.0); p = p * r + SC(1.0 / 39916800.0); p = p * r + SC(1.0 / 3628800.0); p = p * r + SC(1.0 / 362880.0); p = p * r + SC(1.0 / 40320.0);
    p = p * r + SC(1.0 / 5040.0); p = p * r + SC(1.0 / 720.0); p = p * r + SC(1.0 / 120.0); p = p * r + SC(1.0 / 24.0); p = p * r + SC(1.0 / 6.0); p = p * r + SC(0.5); p = p * r + SC(1.0); p = p * r + SC(1.0);
    const long long e = (long long)(1023 + (int)n) << 52;
    return p * __builtin_bit_cast(double, e);
}
__device__ __forceinline__ void dsincos_(double x, double& s, double& c) {
    const double kf = __builtin_rint(x * SC(0.63661977236758134308));
    const double r = (x - kf * SC(1.57079632673412561417)) - kf * SC(6.07710050650619224932e-11);
    const double z = r * r;
    double ps = SC(1.0 / 355687428096000.0);
    ps = ps * z - SC(1.0 / 1307674368000.0); ps = ps * z + SC(1.0 / 6227020800.0); ps = ps * z - SC(1.0 / 39916800.0); ps = ps * z + SC(1.0 / 362880.0); ps = ps * z - SC(1.0 / 5040.0); ps = ps * z + SC(1.0 / 120.0); ps = ps * z - SC(1.0 / 6.0);
    const double sr = r + r * z * ps;
    double pc = -SC(1.0 / 6402373705728000.0);
    pc = pc * z + SC(1.0 / 20922789888000.0); pc = pc * z - SC(1.0 / 87178291200.0); pc = pc * z + SC(1.0 / 479001600.0); pc = pc * z - SC(1.0 / 3628800.0); pc = pc * z + SC(1.0 / 40320.0); pc = pc * z - SC(1.0 / 720.0); pc = pc * z + SC(1.0 / 24.0); pc = pc * z - SC(0.5);
    const double cr = SC(1.0) + z * pc;
    const int k = ((int)kf) & 3;
    s = (k == 0) ? sr : (k == 1) ? cr : (k == 2) ? -sr : -cr;
    c = (k == 0) ? cr : (k == 1) ? -sr : (k == 2) ? -cr : sr;
}

__device__ __forceinline__ void transpose_tile(const float* W, int K, int N, bf16_t* WT, LAS float* T_, int item, int lane, int wave) {
    const int nnb = N / 256, kb = item / nnb, nb = item % nnb, k0 = 128 * kb, n0 = 256 * nb;
    __syncthreads();
#pragma unroll 1
    for (int hb = 0; hb < 16; hb += 8) { float tv[8][4];
#pragma unroll
        for (int i = 0; i < 8; ++i)
#pragma unroll
            for (int j = 0; j < 4; ++j) tv[i][j] = __builtin_nontemporal_load(W + (size_t)(k0 + wave * 16 + hb + i) * N + n0 + lane + 64 * j);
#pragma unroll
        for (int i = 0; i < 8; ++i)
#pragma unroll
            for (int j = 0; j < 4; ++j) T_[(wave * 16 + hb + i) * 257 + lane + 64 * j] = tv[i][j]; }
    __syncthreads();
    const int c = lane & 15;
#pragma unroll
    for (int j = 0; j < 8; ++j) { const int n = (lane >> 4) + 4 * wave + 32 * j; const LAS float* s = T_ + (8 * c) * 257 + n;
        u32x4 o; o.x = pk2(s[0 * 257], s[1 * 257]); o.y = pk2(s[2 * 257], s[3 * 257]); o.z = pk2(s[4 * 257], s[5 * 257]); o.w = pk2(s[6 * 257], s[7 * 257]);
        *(u32x4*)(WT + (size_t)(n0 + n) * K + k0 + 8 * c) = o; }
}
__device__ __forceinline__ void transpose_weights(CArgs a, LAS unsigned char* lds, int lo, int hi, int lane, int wave, int wi, int nw) {
    LAS float* T_ = (LAS float*)lds;
    constexpr int I_IN = 16 * 13, I_OUT = 16 * 8, I_F1 = 16 * 32, I_F2 = 64 * 8, I_GL = 4 * 2, I_L = I_IN + I_OUT + I_F1 + I_F2 + I_GL;
    for (int it = lo + wi; it < hi; it += nw) {
        const int l = it / I_L; int r = it - l * I_L; unsigned char* wl = a->ws + WS_W + (size_t)l * WPL;
        if (r < I_IN) { transpose_tile(a->in[12] + (size_t)l * D * NIN, D, NIN, (bf16_t*)(wl + W_IN), T_, r, lane, wave); continue; } r -= I_IN;
        if (r < I_OUT) { transpose_tile(a->in[27] + (size_t)l * D * D, D, D, (bf16_t*)(wl + W_OUT), T_, r, lane, wave); continue; } r -= I_OUT;
        if (r < I_F1) { transpose_tile(a->in[28] + (size_t)l * D * DFF, D, DFF, (bf16_t*)(wl + W_FF1), T_, r, lane, wave); continue; } r -= I_F1;
        if (r < I_F2) { transpose_tile(a->in[29] + (size_t)l * DFF * D, DFF, D, (bf16_t*)(wl + W_FF2), T_, r, lane, wave); continue; } r -= I_F2;
        transpose_tile(a->in[21] + (size_t)l * 512 * 512, 512, 512, (bf16_t*)(wl + W_GLU), T_, r, lane, wave);
    }
    __syncthreads();
}
constexpr int TR_ITEMS = 2 * (16 * 13 + 16 * 8 + 16 * 32 + 64 * 8 + 4 * 2);

__device__ __forceinline__ void phase0(CArgs a, LAS unsigned char* lds, int tid, int lane, int wave, int G, int bx) {
    unsigned char* ws = a->ws;
    for (int it = bx; it < 192; it += G) {
        const int l = it / 96, cb = it % 96;
        LAS float* S = (LAS float*)lds;
        f32x2 acc[NB];
#pragma unroll
        for (int r = 0; r < NB; ++r) acc[r] = (f32x2){0.f, 0.f};
        const float* Wl = a->in[10] + (size_t)l * D * NMOD + cb * 128 + lane * 2;
        for (int half = 0; half < 2; ++half) {
            __syncthreads();
            for (int idx = tid; idx < NB * 1024; idx += 512) { const int r = idx >> 10, k = idx & 1023;
                const float c = r < 2 ? a->in[7][r * D + half * 1024 + k] : a->in[8][(r - 2) * D + half * 1024 + k];
                S[idx] = c / (1.0f + __expf(-c)); }
            __syncthreads();
            const int kb = wave * 128;
            for (int kk = 0; kk < 128; kk += 16) {
                const int k = kb + kk; const float* wp = Wl + (size_t)(half * 1024 + k) * NMOD;
                f32x2 wv[16];
#pragma unroll
                for (int i = 0; i < 16; ++i) wv[i] = __builtin_nontemporal_load((const f32x2*)(wp + (size_t)i * NMOD));
#pragma unroll
                for (int q = 0; q < 4; ++q) {
#pragma unroll
                    for (int r = 0; r < NB; ++r) { const f32x4 s4 = *(const LAS f32x4*)(S + r * 1024 + k + 4 * q);
                        acc[r] += wv[4 * q] * s4[0]; acc[r] += wv[4 * q + 1] * s4[1]; acc[r] += wv[4 * q + 2] * s4[2]; acc[r] += wv[4 * q + 3] * s4[3]; } }
            }
        }
        __syncthreads();
#pragma unroll
        for (int r = 0; r < NB; ++r) *(LAS f32x2*)(S + (wave * NB + r) * 128 + lane * 2) = acc[r];
        __syncthreads();
        float* MOD = (float*)(ws + WS_MOD);
        for (int idx = tid; idx < NB * 128; idx += 512) { const int r = idx >> 7, col = idx & 127; float s = a->in[11][l * NMOD + cb * 128 + col];
#pragma unroll
            for (int w = 0; w < 8; ++w) s += S[(w * NB + r) * 128 + col];
            MOD[(size_t)(l * NB + r) * NMOD + cb * 128 + col] = s; }
        __syncthreads();
    }
    if (bx == G - 1) {
        float* BL = (float*)(ws + WS_BIAS);
        for (int idx = tid; idx < 4096; idx += 512) { const int h = idx >> 8, ri = idx & 255; const int rel = ri - 191; const int n = rel < 0 ? -rel : rel;
            int bk; if (n < 8) bk = n; else { int far = 8 + (int)(logf((float)n * 0.125f) / 2.0794415416798357f * 8.0f); bk = far < 15 ? far : 15; }
            if (rel > 0) bk += 16;
            BL[idx] = a->in[9][bk * 16 + h]; }
    }
    __syncthreads();
    transpose_weights(a, lds, 0, G == 256 ? TR_ITEMS / 2 : TR_ITEMS, lane, wave, bx, G);
}

__device__ __forceinline__ void rownorm_phase(const XBuf xin, const float* mod_shift, const float* mod_scale, bf16_t* XN, int lane, int gw, int NGW) {
    for (int row0 = gw * 2; row0 < T; row0 += NGW * 2) {
        const int bi = batch_of(row0);
        float v[2][4][8]; float ss0 = 0.f, ss1 = 0.f;
#pragma unroll
        for (int j = 0; j < 4; ++j) { xload8(xin, row0, 8 * lane + 512 * j, v[0][j]); xload8(xin, row0 + 1, 8 * lane + 512 * j, v[1][j]); }
#pragma unroll
        for (int j = 0; j < 4; ++j)
#pragma unroll
            for (int k = 0; k < 8; ++k) { ss0 += v[0][j][k] * v[0][j][k]; ss1 += v[1][j][k] * v[1][j][k]; }
        const float rs0 = rsqrtf(wave_sum(ss0) * (1.0f / D) + EPS), rs1 = rsqrtf(wave_sum(ss1) * (1.0f / D) + EPS);
        const float* sh = mod_shift + (size_t)bi * NMOD; const float* sc = mod_scale + (size_t)bi * NMOD;
#pragma unroll
        for (int j = 0; j < 4; ++j) { const int c = 8 * lane + 512 * j;
            const f32x4 s0 = 1.0f + *(const f32x4*)(sc + c), s1 = 1.0f + *(const f32x4*)(sc + c + 4), h0 = *(const f32x4*)(sh + c), h1 = *(const f32x4*)(sh + c + 4);
            u32x4 w0, w1;
            w0.x = pk2(v[0][j][0] * rs0 * s0[0] + h0[0], v[0][j][1] * rs0 * s0[1] + h0[1]); w0.y = pk2(v[0][j][2] * rs0 * s0[2] + h0[2], v[0][j][3] * rs0 * s0[3] + h0[3]);
            w0.z = pk2(v[0][j][4] * rs0 * s1[0] + h1[0], v[0][j][5] * rs0 * s1[1] + h1[1]); w0.w = pk2(v[0][j][6] * rs0 * s1[2] + h1[2], v[0][j][7] * rs0 * s1[3] + h1[3]);
            w1.x = pk2(v[1][j][0] * rs1 * s0[0] + h0[0], v[1][j][1] * rs1 * s0[1] + h0[1]); w1.y = pk2(v[1][j][2] * rs1 * s0[2] + h0[2], v[1][j][3] * rs1 * s0[3] + h0[3]);
            w1.z = pk2(v[1][j][4] * rs1 * s1[0] + h1[0], v[1][j][5] * rs1 * s1[1] + h1[1]); w1.w = pk2(v[1][j][6] * rs1 * s1[2] + h1[2], v[1][j][7] * rs1 * s1[3] + h1[3]);
            *(u32x4*)(XN + (size_t)row0 * D + c) = w0; *(u32x4*)(XN + (size_t)(row0 + 1) * D + c) = w1; }
    }
}

__device__ __forceinline__ void ssm_build(CArgs a, int l, LAS unsigned char* lds, int tid, int G, int bx) {
    LAS float* PR = (LAS float*)lds;
    LAS float* PI = PR + 64 * 65;
    LAS float* WR = PI + 64 * 65;
    LAS float* WI = WR + 1024;
    LAS float* CC = WI + 1024;
    LAS float* KT = CC + 2048;
    bf16_t* MT = (bf16_t*)(a->ws + WS_MT); bf16_t* EM = (bf16_t*)(a->ws + WS_EM); float* A64 = (float*)(a->ws + WS_A64);
    for (int it = bx; it < 256; it += G) {
        const int g = it >> 3, part = it & 7;
        __syncthreads();
        if (tid < 64) { const int p = tid;
            const double dt = dexp_((double)a->in[15][l * 32 + g]);
            const double ar = (double)a->in[13][(l * 32 + g) * 64 + p], ai = (double)a->in[14][(l * 32 + g) * 64 + p];
            const double mag = dexp_(dt * ar); double sn, cs; dsincos_(dt * ai, sn, cs);
            const double abr = mag * cs, abi = mag * sn, den = ar * ar + ai * ai;
            const double fr = ((abr - 1.0) * ar + abi * ai) / den, fi = (abi * ar - (abr - 1.0) * ai) / den;
            double pr = 1.0, pi = 0.0;
            for (int j = 0; j <= 64; ++j) { PR[p * 65 + j] = (float)pr; PI[p * 65 + j] = (float)pi; const double nr = pr * abr - pi * abi, ni = pr * abi + pi * abr; pr = nr; pi = ni; }
            if (part == 0) { A64[(g * 64 + p) * 2] = PR[p * 65 + 64]; A64[(g * 64 + p) * 2 + 1] = PI[p * 65 + 64]; }
            for (int hi = 0; hi < 16; ++hi) { const double br = (double)a->in[16][((size_t)(l * 32 + g) * 64 + p) * 16 + hi], bi = (double)a->in[17][((size_t)(l * 32 + g) * 64 + p) * 16 + hi];
                WR[p * 16 + hi] = (float)(fr * br - fi * bi); WI[p * 16 + hi] = (float)(fr * bi + fi * br); }
        }
        for (int idx = tid; idx < 1024; idx += 512) { const int ho = idx >> 6, p = idx & 63; CC[p * 32 + ho * 2] = a->in[18][(size_t)(l * 32 + g) * 1024 + idx]; CC[p * 32 + ho * 2 + 1] = a->in[19][(size_t)(l * 32 + g) * 1024 + idx]; }
        __syncthreads();
#pragma unroll 1
        for (int r = 0; r < 2; ++r) { const int idx = tid + 512 * r, j = idx >> 4, hi = idx & 15; float acc[16];
#pragma unroll
            for (int ho = 0; ho < 16; ++ho) acc[ho] = 0.f;
#pragma unroll 2
            for (int p = 0; p < 64; ++p) { const float pr = PR[p * 65 + j], pi = PI[p * 65 + j], wr = WR[p * 16 + hi], wi = WI[p * 16 + hi];
                const float tr = pr * wr - pi * wi, ti = pr * wi + pi * wr;
#pragma unroll
                for (int q = 0; q < 8; ++q) { const f32x4 c4 = *(const LAS f32x4*)(CC + p * 32 + q * 4); acc[2 * q] += c4[0] * tr - c4[1] * ti; acc[2 * q + 1] += c4[2] * tr - c4[3] * ti; } }
#pragma unroll
            for (int ho = 0; ho < 16; ++ho) KT[j * 256 + ho * 16 + hi] = acc[ho]; }
        __syncthreads();
        for (int pc = tid; pc < 128 * 160; pc += 512) { const int rl = pc / 160, c8 = pc % 160; const int t = 8 * part + (rl >> 4), ho = rl & 15; const int c0 = c8 * 8; float v[8];
            if (c0 < 1024) { const int s = c0 >> 4, hi0 = c0 & 15;
                if (t >= s) { const f32x4 k0 = *(const LAS f32x4*)(KT + (t - s) * 256 + ho * 16 + hi0), k1 = *(const LAS f32x4*)(KT + (t - s) * 256 + ho * 16 + hi0 + 4);
#pragma unroll
                    for (int k = 0; k < 4; ++k) { v[k] = k0[k]; v[4 + k] = k1[k]; }
                    if (t == s && (ho >> 3) == (hi0 >> 3)) { const float dsk = a->in[20][l * 512 + g * 16 + ho];
#pragma unroll
                        for (int k = 0; k < 8; ++k) v[k] += (hi0 + k == ho) ? dsk : 0.f; }
                } else {
#pragma unroll
                    for (int k = 0; k < 8; ++k) v[k] = 0.f; }
            } else { const int cc = (c0 - 1024) & 127;
#pragma unroll
                for (int k = 0; k < 8; ++k) { const int col = cc + k, ri = col >> 6, p = col & 63; const float pr = PR[p * 65 + t + 1], pi = PI[p * 65 + t + 1], cr = CC[p * 32 + ho * 2], ci = CC[p * 32 + ho * 2 + 1];
                    v[k] = ri == 0 ? (cr * pr - ci * pi) : -(cr * pi + ci * pr); }
            }
            u32x4 w; w.x = pk2(v[0], v[1]); w.y = pk2(v[2], v[3]); w.z = pk2(v[4], v[5]); w.w = pk2(v[6], v[7]);
            *(u32x4*)(MT + ((size_t)(g * 1024 + t * 16 + ho)) * U2_LD + c0) = w; }
        for (int pc = tid; pc < 32 * 128; pc += 512) { const int row = 32 * part + (pc >> 7), c0 = (pc & 127) * 8; float v[8];
            if (row < 128) { const int ri = row >> 6, p = row & 63, s = c0 >> 4, hi0 = c0 & 15; const float pr = PR[p * 65 + 63 - s], pi = PI[p * 65 + 63 - s];
#pragma unroll
                for (int k = 0; k < 8; ++k) { const float wr = WR[p * 16 + hi0 + k], wi = WI[p * 16 + hi0 + k]; v[k] = ri == 0 ? (pr * wr - pi * wi) : (pr * wi + pi * wr); }
            } else {
#pragma unroll
                for (int k = 0; k < 8; ++k) v[k] = 0.f; }
            u32x4 w; w.x = pk2(v[0], v[1]); w.y = pk2(v[2], v[3]); w.z = pk2(v[4], v[5]); w.w = pk2(v[6], v[7]);
            *(u32x4*)(EM + ((size_t)(g * 256 + row)) * 1024 + c0) = w; }
    }
    __syncthreads();
}

__device__ __forceinline__ void put_hin(bf16_t* U2, int g, int cr, int p, float hr, float hi) {
    bf16_t* d = U2 + (size_t)(g * U2_ROWS + cr) * U2_LD + 1024 + p;
    const unsigned rh = f2bf(hr), ih = f2bf(hi);
    const float rl = hr - __builtin_bit_cast(float, rh << 16), il = hi - __builtin_bit_cast(float, ih << 16);
    d[0] = (bf16_t)rh; d[64] = (bf16_t)ih; d[128] = (bf16_t)f2bf(rl); d[192] = (bf16_t)f2bf(il);
}
__device__ __forceinline__ void carry_phase(CArgs a, int l, LAS unsigned char* lds, int tid, int lane, int wave, int G, int bx) {
    bf16_t* U2 = (bf16_t*)(a->ws + WS_U2); const float* E = (const float*)(a->ws + WS_E); const float* A64 = (const float*)(a->ws + WS_A64);
    LAS float* SE = (LAS float*)lds;
    for (int it = bx; it < 192; it += G) {
        if (it < 64) {
            const int b = it >> 5, g = it & 31, p = lane, seg = wave;
            const float ar = A64[(g * 64 + p) * 2], ai = A64[(g * 64 + p) * 2 + 1];
            float er[32], ei[32];
#pragma unroll
            for (int k = 0; k < 32; ++k) { const size_t ro = (size_t)(g * U2_ROWS + b * 256 + seg * 32 + k) * 256; er[k] = E[ro + p]; ei[k] = E[ro + 64 + p]; }
            float hr = 0.f, hi = 0.f;
#pragma unroll
            for (int k = 0; k < 32; ++k) { const float nr = ar * hr - ai * hi + er[k], ni = ar * hi + ai * hr + ei[k]; hr = nr; hi = ni; }
            __syncthreads();
            SE[(seg * 64 + p) * 2] = hr; SE[(seg * 64 + p) * 2 + 1] = hi;
            __syncthreads();
            float br = ar, bi = ai;
#pragma unroll
            for (int q = 0; q < 5; ++q) { const float nr = br * br - bi * bi, ni = 2.f * br * bi; br = nr; bi = ni; }
            float cr_ = 0.f, ci_ = 0.f;
            for (int s2 = 0; s2 < seg; ++s2) { const float sr = SE[(s2 * 64 + p) * 2], si = SE[(s2 * 64 + p) * 2 + 1]; const float nr = br * cr_ - bi * ci_ + sr, ni = br * ci_ + bi * cr_ + si; cr_ = nr; ci_ = ni; }
            hr = cr_; hi = ci_;
#pragma unroll
            for (int k = 0; k < 32; ++k) { put_hin(U2, g, b * 256 + seg * 32 + k, p, hr, hi);
                const float nr = ar * hr - ai * hi + er[k], ni = ar * hi + ai * hr + ei[k]; hr = nr; hi = ni; }
            if (seg == 7) { a->out[O_SRP + (size_t)((l * 2 + b) * 32 + g) * 64 + p] = hr; a->out[O_SIP + (size_t)((l * 2 + b) * 32 + g) * 64 + p] = hi; }
        } else {
            const int idx = it - 64, sb = idx >> 2, g = (idx & 3) * 8 + wave, p = lane;
            const float ar = A64[(g * 64 + p) * 2], ai = A64[(g * 64 + p) * 2 + 1];
            const size_t so = (size_t)((l * 32 + sb) * 32 + g) * 64 + p;
            const float hr = a->in[4][so], hi = a->in[5][so];
            put_hin(U2, g, 512 + sb, p, hr, hi);
            const size_t ro = (size_t)(g * U2_ROWS + 512 + sb) * 256;
            a->out[O_SRS + so] = ar * hr - ai * hi + E[ro + p]; a->out[O_SIS + so] = ar * hi + ai * hr + E[ro + 64 + p];
        }
    }
    __syncthreads();
}

__device__ __forceinline__ void conv_phase(CArgs a, int l, int lane, int gw, int NGW) {
    const bf16_t* PROJ = (const bf16_t*)(a->ws + WS_PROJ); bf16_t* YC = (bf16_t*)(a->ws + WS_XN);
    const int ch = lane * 8;
    float w0[8], w1[8], w2[8], og[8];
#pragma unroll
    for (int k = 0; k < 8; ++k) { const float* cw = a->in[25] + (size_t)(l * 512 + ch + k) * 3; w0[k] = cw[0]; w1[k] = cw[1]; w2[k] = cw[2]; og[k] = a->in[26][l * D + 1536 + ch + k]; }
#pragma unroll 4
    for (int tok = gw; tok < T; tok += NGW) {
        const bool pr = tok < TP; const int tl = pr ? (tok & (SEQ - 1)) : ((tok - TP) & 63); const int sb = pr ? 0 : ((tok - TP) >> 6);
        float z[3][8];
#pragma unroll
        for (int k = 0; k < 3; ++k) {
            if (tl - k >= 0) { const bf16_t* r = PROJ + (size_t)(tok - k) * NPJ; float gc[8], xc[8]; unpack8(*(const u32x4*)(r + PJ_GC + ch), gc); unpack8(*(const u32x4*)(r + PJ_XC + ch), xc);
#pragma unroll
                for (int j = 0; j < 8; ++j) z[k][j] = gc[j] * xc[j];
            } else if (pr) {
#pragma unroll
                for (int j = 0; j < 8; ++j) z[k][j] = 0.f;
            } else { const float* cb = a->in[6] + (size_t)((l * 32 + sb) * 2 + (tl - k + 2)) * 512 + ch; const f32x4 c0 = *(const f32x4*)cb, c1 = *(const f32x4*)(cb + 4);
#pragma unroll
                for (int j = 0; j < 4; ++j) { z[k][j] = c0[j]; z[k][4 + j] = c1[j]; } }
        }
        float gb[8]; unpack8(*(const u32x4*)(PROJ + (size_t)tok * NPJ + PJ_GB + ch), gb);
        float y[8], ss = 0.f;
#pragma unroll
        for (int j = 0; j < 8; ++j) { y[j] = gb[j] * (w0[j] * z[2][j] + w1[j] * z[1][j] + w2[j] * z[0][j]); ss += y[j] * y[j]; }
        const float rs = rsqrtf(wave_sum(ss) * (1.0f / 512.0f) + EPS);
        u32x4 w; w.x = pk2(y[0] * rs * og[0], y[1] * rs * og[1]); w.y = pk2(y[2] * rs * og[2], y[3] * rs * og[3]); w.z = pk2(y[4] * rs * og[4], y[5] * rs * og[5]); w.w = pk2(y[6] * rs * og[6], y[7] * rs * og[7]);
        *(u32x4*)(YC + (size_t)tok * D + 1536 + ch) = w;
        const int last = pr ? SEQ - 2 : 62;
        if (tl >= last) { float* dst = pr ? a->out + O_NCP + (size_t)((l * 2 + (tok >> 14)) * 2 + (tl - last)) * 512 + ch : a->out + O_NCS + (size_t)((l * 32 + sb) * 2 + (tl - last)) * 512 + ch;
            *(f32x4*)dst = (f32x4){z[0][0], z[0][1], z[0][2], z[0][3]}; *(f32x4*)(dst + 4) = (f32x4){z[0][4], z[0][5], z[0][6], z[0][7]}; }
    }
}
__device__ __forceinline__ void ssmnorm_phase(CArgs a, int l, int lane, int gw, int NGW) {
    const float* YT = (const float*)(a->ws + WS_YT); bf16_t* YC = (bf16_t*)(a->ws + WS_XN);
    const int ch = lane * 8; const f32x4 g0 = *(const f32x4*)(a->in[26] + l * D + ch), g1 = *(const f32x4*)(a->in[26] + l * D + ch + 4);
#pragma unroll 2
    for (int tok = gw; tok < T; tok += NGW) {
        const f32x4 v0 = *(const f32x4*)(YT + (size_t)tok * 512 + ch), v1 = *(const f32x4*)(YT + (size_t)tok * 512 + ch + 4);
        float ss = (v0[0] * v0[0] + v0[1] * v0[1]) + (v0[2] * v0[2] + v0[3] * v0[3]) + (v1[0] * v1[0] + v1[1] * v1[1]) + (v1[2] * v1[2] + v1[3] * v1[3]);
        const float rs = rsqrtf(wave_sum(ss) * (1.0f / 512.0f) + EPS);
        const f32x4 o0 = v0 * rs * g0, o1 = v1 * rs * g1;
        u32x4 w; w.x = pk2(o0[0], o0[1]); w.y = pk2(o0[2], o0[3]); w.z = pk2(o1[0], o1[1]); w.w = pk2(o1[2], o1[3]);
        *(u32x4*)(YC + (size_t)tok * D + ch) = w;
    }
}

constexpr int AT_KS = 0, AT_VT = 55296, AT_BL = 106496, AT_RED = 122880;
__device__ __forceinline__ int crow(int r, int h) { return (r & 3) + 8 * (r >> 2) + 4 * h; }
__device__ __forceinline__ void attn_phase(CArgs a, int l, LAS unsigned char* lds, int tid, int lane, int wave, int G, int bx) {
    const bf16_t* PROJ = (const bf16_t*)(a->ws + WS_PROJ); bf16_t* YC = (bf16_t*)(a->ws + WS_XN);
    LAS bf16_t* Ks = (LAS bf16_t*)(lds + AT_KS);
    LAS bf16_t* Vt = (LAS bf16_t*)(lds + AT_VT);
    LAS float* BL = (LAS float*)(lds + AT_BL);
    LAS float* RED = (LAS float*)(lds + AT_RED);
    const float* BLg = (const float*)(a->ws + WS_BIAS);
    for (int idx = tid; idx < 4096; idx += 512) BL[idx] = BLg[idx];
    const int ql = lane & 31, hf = lane >> 5;
    for (int it = (bx + 64) % G; it < 1088; it += G) {
        int ll = l; asm volatile("" : "+s"(ll));
        const bool pr = it < 1024; const int half = it & 1;
        const int bc = pr ? (it >> 1) : 0, c = bc & 255, b = bc >> 8, sb = pr ? 0 : ((it - 1024) >> 1);
        const int token0 = (pr ? bc * 64 : TP + sb * 64) + half * 32;
        __syncthreads();
        u32x4 rk[3][2], rv[3][2];
#pragma unroll
        for (int pass = 0; pass < 3; ++pass) {
            const int idx = tid + 512 * pass, row = idx >> 2, qd = idx & 3, kvh = row >= 192 ? 1 : 0, s = row - 192 * kvh, d0 = qd * 16;
            if (pr) { if ((c * 64 - 128 + s) >= 0) { const bf16_t* r = PROJ + (size_t)(bc * 64 - 128 + s) * NPJ;
                    rk[pass][0] = *(const u32x4*)(r + PJ_K + kvh * 64 + d0); rk[pass][1] = *(const u32x4*)(r + PJ_K + kvh * 64 + d0 + 8);
                    rv[pass][0] = *(const u32x4*)(r + PJ_V + kvh * 64 + d0); rv[pass][1] = *(const u32x4*)(r + PJ_V + kvh * 64 + d0 + 8); } }
            else if (s >= 128) { const bf16_t* r = PROJ + (size_t)(TP + sb * 64 + (s - 128)) * NPJ;
                rk[pass][0] = *(const u32x4*)(r + PJ_K + kvh * 64 + d0); rk[pass][1] = *(const u32x4*)(r + PJ_K + kvh * 64 + d0 + 8);
                rv[pass][0] = *(const u32x4*)(r + PJ_V + kvh * 64 + d0); rv[pass][1] = *(const u32x4*)(r + PJ_V + kvh * 64 + d0 + 8); }
        }
#pragma unroll
        for (int pass = 0; pass < 3; ++pass) {
            const int idx = tid + 512 * pass, row = idx >> 2, qd = idx & 3, kvh = row >= 192 ? 1 : 0, s = row - 192 * kvh, d0 = qd * 16;
            float kv[16], vv[16]; bool fromproj = false;
            if (pr) fromproj = (c * 64 - 128 + s) >= 0; else fromproj = s >= 128;
            if (fromproj) { unpack8(rk[pass][0], kv); unpack8(rk[pass][1], kv + 8); unpack8(rv[pass][0], vv); unpack8(rv[pass][1], vv + 8); }
            else if (!pr) { const size_t co = ((size_t)((ll * 32 + sb) * 128 + s) * 2 + kvh) * 64 + d0;
#pragma unroll
                for (int q = 0; q < 4; ++q) { const f32x4 k4 = *(const f32x4*)(a->in[2] + co + 4 * q), v4 = *(const f32x4*)(a->in[3] + co + 4 * q);
#pragma unroll
                    for (int j = 0; j < 4; ++j) { kv[4 * q + j] = k4[j]; vv[4 * q + j] = v4[j]; } }
            } else {
#pragma unroll
                for (int j = 0; j < 16; ++j) { kv[j] = 0.f; vv[j] = 0.f; } }
            float ss = 0.f;
#pragma unroll
            for (int j = 0; j < 16; ++j) ss += kv[j] * kv[j];
            ss += __shfl_xor(ss, 1); ss += __shfl_xor(ss, 2);
            if (fromproj) { const float rs = rsqrtf(ss * (1.0f / 64.0f) + EPS);
#pragma unroll
                for (int j = 0; j < 16; ++j) kv[j] = kv[j] * rs * a->in[23][ll * 64 + d0 + j]; }
            LAS bf16_t* kd = Ks + (kvh * 192 + s) * 72 + d0;
            u32x4 w0, w1; w0.x = pk2(kv[0], kv[1]); w0.y = pk2(kv[2], kv[3]); w0.z = pk2(kv[4], kv[5]); w0.w = pk2(kv[6], kv[7]);
            w1.x = pk2(kv[8], kv[9]); w1.y = pk2(kv[10], kv[11]); w1.z = pk2(kv[12], kv[13]); w1.w = pk2(kv[14], kv[15]);
            *(LAS u32x4*)kd = w0; *(LAS u32x4*)(kd + 8) = w1;
#pragma unroll
            for (int j = 0; j < 16; j += 2) { const unsigned pv = pk2(vv[j], vv[j + 1]); Vt[(kvh * 64 + d0 + j) * 200 + s] = (bf16_t)(pv & 0xffffu); Vt[(kvh * 64 + d0 + j + 1) * 200 + s] = (bf16_t)(pv >> 16); }
            int wrow = -1; float* nk = nullptr; float* nv = nullptr;
            if (half == 0) {
                if (pr) { if (c >= 254 && s >= 128) { wrow = (c - 254) * 64 + (s - 128); nk = a->out + O_NKP + (size_t)(l * 2 + b) * 128 * 128; nv = a->out + O_NVP + (size_t)(l * 2 + b) * 128 * 128; } }
                else if (s >= 64) { wrow = s - 64; nk = a->out + O_NKS + (size_t)(l * 32 + sb) * 128 * 128; nv = a->out + O_NVS + (size_t)(l * 32 + sb) * 128 * 128; }
            }
            if (wrow >= 0) { const size_t o = (size_t)wrow * 128 + kvh * 64 + d0;
#pragma unroll
                for (int q = 0; q < 4; ++q) { *(f32x4*)(nk + o + 4 * q) = (f32x4){kv[4 * q], kv[4 * q + 1], kv[4 * q + 2], kv[4 * q + 3]}; *(f32x4*)(nv + o + 4 * q) = (f32x4){vv[4 * q], vv[4 * q + 1], vv[4 * q + 2], vv[4 * q + 3]}; } }
        }
        const int kvh = wave >> 2, qtok = token0 + ql, qi = half * 32 + ql;
        u32x4 qraw[4];
#pragma unroll
        for (int st = 0; st < 4; ++st) qraw[st] = *(const u32x4*)(PROJ + (size_t)qtok * NPJ + (2 * wave) * 64 + st * 16 + hf * 8);
        __syncthreads();
        const int nmask = (pr && c < 2) ? 128 - 64 * c : 0;
        float ssq = 0.f;
#pragma unroll 1
        for (int hh = 0; hh < 2; ++hh) {
            const int h = 2 * wave + hh;
            bf16x8 qf[4];
            { float qv[4][8]; float ss = 0.f;
#pragma unroll
                for (int st = 0; st < 4; ++st) unpack8(qraw[st], qv[st]);
                if (hh == 0) {
#pragma unroll
                    for (int st = 0; st < 4; ++st) qraw[st] = *(const u32x4*)(PROJ + (size_t)qtok * NPJ + (h + 1) * 64 + st * 16 + hf * 8); }
#pragma unroll
                for (int st = 0; st < 4; ++st) {
#pragma unroll
                    for (int j = 0; j < 8; ++j) ss += qv[st][j] * qv[st][j]; }
                ss += __shfl_xor(ss, 32);
                const float rs = rsqrtf(ss * (1.0f / 64.0f) + EPS) * 0.125f;
#pragma unroll
                for (int st = 0; st < 4; ++st) { const float* qg = a->in[22] + ll * 64 + st * 16 + hf * 8; u32x4 w;
                    w.x = pk2(qv[st][0] * rs * qg[0], qv[st][1] * rs * qg[1]); w.y = pk2(qv[st][2] * rs * qg[2], qv[st][3] * rs * qg[3]);
                    w.z = pk2(qv[st][4] * rs * qg[4], qv[st][5] * rs * qg[5]); w.w = pk2(qv[st][6] * rs * qg[6], qv[st][7] * rs * qg[7]);
                    qf[st] = __builtin_bit_cast(bf16x8, w); } }
            const float sink = a->in[24][ll * 16 + h]; float mx = sink, sum = 0.f;
            const LAS float* blh = BL + h * 256 + 63 - qi;
            f32x16 o0, o1;
#pragma unroll
            for (int i = 0; i < 16; ++i) { o0[i] = 0.f; o1[i] = 0.f; }
#pragma unroll
            for (int ps = 0; ps < 6; ++ps) {
                asm volatile("" ::: "memory");
                float sv[1][16];
#pragma unroll
                for (int t3 = 0; t3 < 1; ++t3) { const int tt = ps + t3; f32x16 sa;
#pragma unroll
                    for (int i = 0; i < 16; ++i) sa[i] = 0.f;
#pragma unroll
                    for (int st = 0; st < 4; ++st) { const bf16x8 kf = *(const LAS bf16x8*)(Ks + (kvh * 192 + tt * 32 + ql) * 72 + st * 16 + hf * 8);
                        sa = __builtin_amdgcn_mfma_f32_32x32x16_bf16(kf, qf[st], sa, 0, 0, 0); }
#pragma unroll
                    for (int i = 0; i < 16; ++i) sv[t3][i] = sa[i]; }
                float mn = mx;
#pragma unroll
                for (int t3 = 0; t3 < 1; ++t3)
#pragma unroll
                    for (int i = 0; i < 16; ++i) { const int s = (ps + t3) * 32 + crow(i, hf); float v = sv[t3][i] + blh[s]; if (s < nmask) v = -1e30f; sv[t3][i] = v; mn = fmaxf(mn, v); }
                mn = fmaxf(mn, __shfl_xor(mn, 32));
                const float resc = __expf(mx - mn); mx = mn;
                float psum = 0.f;
#pragma unroll
                for (int t3 = 0; t3 < 1; ++t3)
#pragma unroll
                    for (int i = 0; i < 16; ++i) { const float p = __expf(sv[t3][i] - mx); sv[t3][i] = p; psum += p; }
                sum = sum * resc + psum;
                o0 = o0 * resc; o1 = o1 * resc;
#pragma unroll
                for (int t3 = 0; t3 < 1; ++t3)
#pragma unroll
                    for (int bb = 0; bb < 2; ++bb) { const int tt = ps + t3;
                        u32x4 pw; pw.x = pk2(sv[t3][8 * bb], sv[t3][8 * bb + 1]); pw.y = pk2(sv[t3][8 * bb + 2], sv[t3][8 * bb + 3]); pw.z = pk2(sv[t3][8 * bb + 4], sv[t3][8 * bb + 5]); pw.w = pk2(sv[t3][8 * bb + 6], sv[t3][8 * bb + 7]);
                        const bf16x8 pf = __builtin_bit_cast(bf16x8, pw);
                        const LAS bf16_t* v0p = Vt + (kvh * 64 + ql) * 200 + tt * 32 + 16 * bb + 4 * hf;
                        const LAS bf16_t* v1p = v0p + 32 * 200;
                        u32x4 a0, a1; { const u32x2 lo = *(const LAS u32x2*)v0p, hi = *(const LAS u32x2*)(v0p + 8); a0.x = lo.x; a0.y = lo.y; a0.z = hi.x; a0.w = hi.y; }
                        { const u32x2 lo = *(const LAS u32x2*)v1p, hi = *(const LAS u32x2*)(v1p + 8); a1.x = lo.x; a1.y = lo.y; a1.z = hi.x; a1.w = hi.y; }
                        o0 = __builtin_amdgcn_mfma_f32_32x32x16_bf16(__builtin_bit_cast(bf16x8, a0), pf, o0, 0, 0, 0);
                        o1 = __builtin_amdgcn_mfma_f32_32x32x16_bf16(__builtin_bit_cast(bf16x8, a1), pf, o1, 0, 0, 0);
                    }
            }
            sum += __shfl_xor(sum, 32);
            const float inv = 1.0f / (sum + __expf(sink - mx));
            o0 = o0 * inv; o1 = o1 * inv;
#pragma unroll
            for (int i = 0; i < 16; ++i) ssq += o0[i] * o0[i] + o1[i] * o1[i];
#pragma unroll
            for (int i4 = 0; i4 < 4; ++i4) { const int col = 512 + h * 64 + 8 * i4 + 4 * hf;
                u32x2 w; w.x = pk2(o0[4 * i4], o0[4 * i4 + 1]); w.y = pk2(o0[4 * i4 + 2], o0[4 * i4 + 3]); *(u32x2*)(YC + (size_t)qtok * D + col) = w;
                u32x2 w2; w2.x = pk2(o1[4 * i4], o1[4 * i4 + 1]); w2.y = pk2(o1[4 * i4 + 2], o1[4 * i4 + 3]); *(u32x2*)(YC + (size_t)qtok * D + col + 32) = w2; }
        }
        ssq += __shfl_xor(ssq, 32);
        if (lane < 32) RED[wave * 32 + ql] = ssq;
        asm volatile("s_waitcnt vmcnt(0)" ::: "memory");
        __syncthreads();
        float tot = 0.f;
#pragma unroll
        for (int w = 0; w < 8; ++w) tot += RED[w * 32 + ql];
        const float rs = rsqrtf(tot * (1.0f / 1024.0f) + EPS);
        { u32x2 yw[16]; bf16_t* yb = YC + (size_t)qtok * D + 512 + wave * 128 + 4 * hf;
#pragma unroll
          for (int k8 = 0; k8 < 16; ++k8) yw[k8] = *(const u32x2*)(yb + 8 * k8);
#pragma unroll
          for (int k8 = 0; k8 < 16; ++k8) { const f32x4 g4 = *(const f32x4*)(a->in[26] + ll * D + 512 + wave * 128 + 8 * k8 + 4 * hf);
              u32x2 w; w.x = pk2(bflo(yw[k8].x) * rs * g4[0], bfhi(yw[k8].x) * rs * g4[1]); w.y = pk2(bflo(yw[k8].y) * rs * g4[2], bfhi(yw[k8].y) * rs * g4[3]);
              *(u32x2*)(yb + 8 * k8) = w; } }
    }
    __syncthreads();
}


template <class Order>
__device__ __forceinline__ void reduce_tail(const Order& S, const float* PART, const float* gate, const XBuf xin, const XBuf xout, int lane, int wave, int G, int bx) {
    const int rows = 256 / S.split;
    for (int it = bx; it < (S.nwg - S.nfull) * S.split; it += G) { int pm, pn; S.tile_of(S.nfull + it / S.split, pm, pn);
        const int r0 = (it % S.split) * rows, c8 = (lane & 31) * 8;
        for (int rl = r0 + wave * 2 + (lane >> 5); rl < r0 + rows; rl += 16) { const int row = pm * 256 + rl, col = pn * 256 + c8;
            f32x4 s0 = {0.f, 0.f, 0.f, 0.f}, s1 = {0.f, 0.f, 0.f, 0.f};
            for (int p = 0; p < S.split; ++p) { const float* pp = PART + ((size_t)((it / S.split) * S.split + p) * 256 + rl) * 256 + c8; s0 += *(const f32x4*)pp; s1 += *(const f32x4*)(pp + 4); }
            const float* gp = gate + (size_t)batch_of(row) * NMOD + col; const f32x4 g0 = *(const f32x4*)gp, g1 = *(const f32x4*)(gp + 4);
            float xv[8], o[8]; xload8(xin, row, col, xv);
#pragma unroll
            for (int j = 0; j < 4; ++j) { o[j] = xv[j] + g0[j] * s0[j]; o[4 + j] = xv[4 + j] + g1[j] * s1[j]; }
            xstore8(xout, row, col, o); } }
}

#define XB_TMO      128
#define XB_XCNT(j)  (256  + 64 * (j))
#define XB_XSUB(j)  (1280 + 64 * (j))
#define XB_XGEN(j)  (2304 + 64 * (j))
#define XB_TOP      3328
#define XB_TOPGEN   3392
#define XCD_BAR_WORDS 3456
#define XB_SPIN_CAP (1u << 22)
__device__ __forceinline__ unsigned xb_ld(unsigned* p)              { return __hip_atomic_load(p, __ATOMIC_RELAXED, __HIP_MEMORY_SCOPE_AGENT); }
__device__ __forceinline__ unsigned xb_add(unsigned* p, unsigned v) { return __hip_atomic_fetch_add(p, v, __ATOMIC_RELAXED, __HIP_MEMORY_SCOPE_AGENT); }
__device__ __forceinline__ unsigned xb_xcc_id() { return (unsigned)__builtin_amdgcn_s_getreg((3 << 11) | 20) & 0xFu; }
#define XB_SPIN(cond, bar) do { unsigned _sp = 0; while (cond) { __builtin_amdgcn_s_sleep(1); \
    if ((++_sp & 255u) == 0u) { if (xb_ld(&(bar)[XB_TMO])) break; if (_sp > XB_SPIN_CAP) { atomicAdd(&(bar)[XB_TMO], 1u); break; } } } } while (0)
struct XcdBarrier { unsigned* bar; unsigned x; volatile LAS unsigned* st; };
__device__ __forceinline__ XcdBarrier xcd_barrier_post(unsigned* bar, volatile LAS unsigned* st) {
    XcdBarrier b; b.bar = bar; b.x = xb_xcc_id(); b.st = st;
    if (threadIdx.x == 0) (void)xb_add(&bar[XB_XCNT(b.x)], 1u);
    return b;
}
__device__ __forceinline__ void xcd_barrier_complete(unsigned* bar, unsigned x, unsigned& nloc, unsigned& nx) {
    const unsigned G = gridDim.x * gridDim.y * gridDim.z;
    unsigned sum, cnt, mine, sp = 0u;
    for (;;) {
        sum = 0u; cnt = 0u; mine = 0u;
#pragma unroll
        for (unsigned j = 0; j < 16; ++j) { const unsigned c = xb_ld(&bar[XB_XCNT(j)]); sum += c; cnt += (c > 0u) ? 1u : 0u; mine = (j == x) ? c : mine; }
        if (sum == G) break;
        __builtin_amdgcn_s_sleep(1);
        if ((++sp & 255u) == 0u) { if (xb_ld(&bar[XB_TMO])) break; if (sp > XB_SPIN_CAP) { atomicAdd(&bar[XB_TMO], 1u); break; } }
    }
    nloc = mine > 0u ? mine : 1u; nx = cnt > 0u ? cnt : 1u;
}
__device__ __forceinline__ void xcd_barrier(const XcdBarrier& b, const int tid) {
    asm volatile("s_waitcnt vmcnt(0)" ::: "memory");
    __syncthreads();
    if (tid == 0) {
        unsigned* bar = b.bar;
        __builtin_amdgcn_s_waitcnt(0);
        unsigned nloc = b.st[0], nx = b.st[1];
        if (nloc == 0u) { xcd_barrier_complete(bar, b.x, nloc, nx); b.st[0] = nloc; b.st[1] = nx; }
        const unsigned old = xb_add(&bar[XB_XSUB(b.x)], 1u);
        const unsigned gen = old / nloc;
        if (old + 1u == (gen + 1u) * nloc) {
            __builtin_amdgcn_fence(__ATOMIC_RELEASE, "agent");
            asm volatile("s_waitcnt vmcnt(0)" ::: "memory");
            const unsigned og = xb_add(&bar[XB_TOP], 1u);
            const unsigned tg = og / nx;
            if (og + 1u == (tg + 1u) * nx) xb_add(&bar[XB_TOPGEN], 1u);
            else XB_SPIN(xb_ld(&bar[XB_TOPGEN]) == tg, bar);
            __builtin_amdgcn_fence(__ATOMIC_ACQUIRE, "agent");
            xb_add(&bar[XB_XGEN(b.x)], 1u);
            asm volatile("s_waitcnt vmcnt(0)" ::: "memory");
        } else {
            XB_SPIN(xb_ld(&bar[XB_XGEN(b.x)]) == gen, bar);
            __builtin_amdgcn_fence(__ATOMIC_ACQUIRE, "agent");
            asm volatile("s_waitcnt vmcnt(0)" ::: "memory");
        }
    }
    __syncthreads();
}
constexpr int LDS_ST_OFF = LDS_BYTES - 64;

__global__ void __launch_bounds__(512, 2) mega(Args a_) {
    extern __shared__ __attribute__((aligned(16))) unsigned char lds_raw[];
    LAS unsigned char* lds = (LAS unsigned char*)lds_raw;
    cg::grid_group grid = cg::this_grid();
    const int ph_lo = a_.ph_lo, ph_hi = a_.ph_hi; int rep = 0; (void)rep;
    volatile LAS unsigned* bst = (volatile LAS unsigned*)(lds + LDS_ST_OFF);
    if (threadIdx.x < 2) bst[threadIdx.x] = 0u;
    __syncthreads();
    const XcdBarrier xbar = xcd_barrier_post((unsigned*)a_.ws, bst);
    const int wave0 = __builtin_amdgcn_readfirstlane((int)(threadIdx.x >> 6));
    for (int ph = ph_lo; ph < ph_hi; ++ph) {
        unsigned zz = 0u; asm volatile("" : "+v"(zz)); int w0 = wave0; asm volatile("" : "+s"(w0));
        int tid = w0 * 64 + (int)__builtin_amdgcn_mbcnt_hi(~0u, __builtin_amdgcn_mbcnt_lo(~0u, zz));
        int bx = blockIdx.x, G = gridDim.x; asm volatile("" : "+s"(bx), "+s"(G));
        CArgs a = (CArgs)__builtin_amdgcn_kernarg_segment_ptr(); asm volatile("" : "+s"(a));
        const int lane = tid & 63, wave = __builtin_amdgcn_readfirstlane(tid >> 6);
        const int gw = bx * 8 + wave, NGW = G * 8;
        unsigned char* ws = a->ws;
        bf16_t* XN = (bf16_t*)(ws + WS_XN);
        if (ph == 0) phase0(a, lds, tid, lane, wave, G, bx);
        else {
            const int l = (ph - 1) / 11, sp = (ph - 1) % 11;
            const float* MODl = (const float*)(ws + WS_MOD) + (size_t)l * NB * NMOD;
            unsigned char* wl = ws + WS_W + (size_t)l * WPL;
            const unsigned char* ob = (const unsigned char*)a->out;
            const XBuf X0{(const unsigned char*)a->in[0], (const unsigned char*)a->in[1] - (size_t)TP * 8192, TP, 1};
            const XBuf XA{ob, ob, 0, 0}, XB{ob + (size_t)T * 4096, ob + (size_t)T * 4096, 0, 0};
            const XBuf XC{ws + 956 * MiB, ws + WS_MT - (size_t)17408 * 4096, 17408, 0}, XY{ob, ob, 0, 1};
            const XBuf xin1 = l == 0 ? X0 : XB;
            const XBuf xmid = l == 0 ? XA : XC;
            const XBuf xend = l == 0 ? XB : XY;
            if (sp == 0) { ssm_build(a, l, lds, tid, G, bx); rownorm_phase(xin1, MODl, MODl + 2048, XN, lane, gw, NGW); }
            else if (sp == 1) { pg8::Gemm g{XN, (const bf16_t*)(wl + W_IN), D, D, D}; pg8::StaticOrder S; S.init(T, NIN, D, G, bx);
                pg8::EpiIn E{(bf16_t*)(ws + WS_U2), (bf16_t*)(ws + WS_PROJ)}; pg8::gemm_phase(lds, tid, g, S, E); }
            else if (sp == 2) { pg8::Gemm g{(const bf16_t*)(ws + WS_U2), (const bf16_t*)(ws + WS_EM), U2_LD, 1024, 1024}; pg8::S1Order S{G, bx};
                pg8::EpiS1 E{(float*)(ws + WS_E)}; pg8::gemm_phase(lds, tid, g, S, E);
                attn_phase(a, l, lds, tid, lane, wave, G, bx);
                conv_phase(a, l, lane, gw, NGW); }
            else if (sp == 3) carry_phase(a, l, lds, tid, lane, wave, G, bx);
            else if (sp == 4) { pg8::Gemm g{(const bf16_t*)(ws + WS_U2), (const bf16_t*)(ws + WS_MT), U2_LD, U2_LD, U2_LD}; pg8::EpiS2 E{(bf16_t*)(ws + WS_YG)};
                if (G == 256) { pg8::S2XcdOrder S{G, bx}; pg8::gemm_phase(lds, tid, g, S, E);
                    if (l == 0 && bx >= 128) transpose_weights(a, lds, TR_ITEMS / 2, TR_ITEMS / 2 + 800, lane, wave, bx - 128, 128); }
                else { pg8::S2Order S{G, bx}; pg8::gemm_phase(lds, tid, g, S, E); } }
            else if (sp == 5) { pg8::Gemm g{(const bf16_t*)(ws + WS_YG), (const bf16_t*)(wl + W_GLU), 512, 512, 512};
                if (G >= T / 256) {
                    LAS float* rss = (LAS float*)(lds + 131072);
                    if (tid < 256) rss[tid] = 0.f;
                    __syncthreads();
                    pg8::GluOrder S{G, bx}; pg8::EpiGlu2 E{(const bf16_t*)(ws + WS_YG), XN, rss}; pg8::gemm_phase(lds, tid, g, S, E);
                    __syncthreads();
                    if (G == 256 && l == 0 && bx >= T / 256) transpose_weights(a, lds, TR_ITEMS / 2 + 800, TR_ITEMS, lane, wave, bx - T / 256, G - T / 256);
                    if (bx < T / 256) { const int wr = wave >> 2, wc = wave & 3, fr = lane & 15, fq = lane >> 4;
#pragma unroll 1
                        for (int pn = 0; pn < 2; ++pn)
#pragma unroll 1
                            for (int bj = 0; bj < 2; ++bj) { const int col = pn * 256 + wc * 32 + 8 * fq + bj * 128;
                                const f32x4 g0 = *(const f32x4*)(a->in[26] + l * D + col), g1 = *(const f32x4*)(a->in[26] + l * D + col + 4);
#pragma unroll
                                for (int am = 0; am < 8; ++am) { const int rl = wr * 64 + fr + (am >> 2) * 128 + (am & 3) * 16; bf16_t* yp = XN + ((size_t)bx * 256 + rl) * D + col;
                                    const float rs = rsqrtf(rss[rl] * (1.0f / 512.0f) + EPS); float y[8]; unpack8(*(const u32x4*)yp, y);
                                    u32x4 w; w.x = pk2(y[0] * rs * g0[0], y[1] * rs * g0[1]); w.y = pk2(y[2] * rs * g0[2], y[3] * rs * g0[3]); w.z = pk2(y[4] * rs * g1[0], y[5] * rs * g1[1]); w.w = pk2(y[6] * rs * g1[2], y[7] * rs * g1[3]);
                                    *(u32x4*)yp = w; } } }
                } else { pg8::StaticOrder S; S.init(T, 512, 512, G, bx);
                    pg8::EpiGlu E{(const bf16_t*)(ws + WS_YG), (float*)(ws + WS_YT)}; pg8::gemm_phase(lds, tid, g, S, E); } }
            else if (sp == 6) { if (G < T / 256) ssmnorm_phase(a, l, lane, gw, NGW); }
            else if (sp == 7 || sp == 10) { const bool o = sp == 7;
                pg8::Gemm g{o ? XN : (const bf16_t*)(ws + WS_HID), (const bf16_t*)(wl + (o ? W_OUT : W_FF2)), o ? D : DFF, o ? D : DFF, o ? D : DFF};
                pg8::StaticOrder S; S.init(T, D, o ? D : DFF, G, bx, true);
                float* PART = (float*)(ws + (o ? WS_HID : WS_XN));
                pg8::EpiRes E{o ? xin1 : xmid, o ? xmid : xend, MODl + (o ? 4096 : 10240), (o ? D : DFF) / 64, PART}; pg8::gemm_phase(lds, tid, g, S, E);
                if (S.split > 1) { xcd_barrier(xbar, tid); reduce_tail(S, PART, MODl + (o ? 4096 : 10240), o ? xin1 : xmid, o ? xmid : xend, lane, wave, G, bx); } }
            else if (sp == 8) rownorm_phase(xmid, MODl + 6144, MODl + 8192, XN, lane, gw, NGW);
            else if (sp == 9) { pg8::Gemm g{XN, (const bf16_t*)(wl + W_FF1), D, D, D}; pg8::EpiFF1 E{(bf16_t*)(ws + WS_HID)};
                if (G == 256) { pg8::FF1Order S{G, bx}; pg8::gemm_phase(lds, tid, g, S, E); }
                else { pg8::StaticOrder S; S.init(T, DFF, D, G, bx); pg8::gemm_phase(lds, tid, g, S, E); } }
        }
        if (ph + 1 < ph_hi && !(ph > 0 && (ph - 1) % 11 == 6 && G >= T / 256)) { if (ph < 0) grid.sync(); else xcd_barrier(xbar, tid); }
#if defined(REP_SYNC)
        xcd_barrier(xbar, tid);
#endif
#if defined(REP_MASK)
        { const int spx = ph == 0 ? 11 : (ph - 1) % 11;
          if (((REP_MASK >> spx) & 1) && !rep) { rep = 1; --ph; } else rep = 0; }
#endif
    }
}

extern "C" void kernel_launch(void* const* d_in, const int* in_sizes, int n_in, void* d_out, int out_size, void* d_ws, size_t ws_size, hipStream_t stream) {
    static int grid = 0;
    if (grid == 0) {
        if (n_in != 30 || (size_t)out_size != O_END || ws_size < WS_END) { fprintf(stderr, "kernel_launch: unexpected shapes: n_in %d out %d (want %zu) ws %zu (want %zu)\n", n_in, out_size, (size_t)O_END, ws_size, (size_t)WS_END); grid = -1; return; }
        int dev = 0, cus = 0, per_cu = 0;
        hipGetDevice(&dev); hipDeviceGetAttribute(&cus, hipDeviceAttributeMultiprocessorCount, dev);
        if (hipFuncSetAttribute((const void*)mega, hipFuncAttributeMaxDynamicSharedMemorySize, LDS_BYTES) != hipSuccess) { fprintf(stderr, "kernel_launch: hipFuncSetAttribute failed\n"); grid = -1; return; }
        if (hipOccupancyMaxActiveBlocksPerMultiprocessor(&per_cu, (const void*)mega, 512, LDS_BYTES) != hipSuccess || per_cu < 1) { fprintf(stderr, "kernel_launch: occupancy query says %d\n", per_cu); per_cu = 1; }
        (void)hipGetLastError();
        grid = cus * per_cu;
    }
    if (grid < 0) return;
    if (hipMemsetAsync(d_ws, 0, 16384, stream) != hipSuccess) { fprintf(stderr, "kernel_launch: memset of the barrier words failed\n"); return; }
    Args a{};
    for (int i = 0; i < 30; ++i) a.in[i] = (const float*)d_in[i];
    a.out = (float*)d_out; a.ws = (unsigned char*)d_ws; a.ph_lo = 0; a.ph_hi = NPH;
    void* args[] = {&a};
    const hipError_t e = hipLaunchCooperativeKernel((const void*)mega, dim3(grid), dim3(512), args, LDS_BYTES, stream);
    if (e != hipSuccess) fprintf(stderr, "kernel_launch: cooperative launch failed: %s (grid %d)\n", hipGetErrorString(e), grid);
}
```
